# Optimizing an MI355X kernel written in HIP

```python
import math
import jax, jax.numpy as jnp
from jax import lax
import numpy as np

D_MODEL = 1024
BATCH = 32
SEQ = 2048
DEPTH = 2

HEAD_DIM = 64
N_HEADS = D_MODEL // HEAD_DIM
MIX_WIDTH = N_HEADS * HEAD_DIM
H_FOX = 5
H_MOBA = 5
H_DIL = N_HEADS - H_FOX - H_MOBA
ROT_DIM = HEAD_DIM // 4
ROPE_THETA = 500000.0
Q_BLOCK = 128
FORGET_BIAS_INIT = 3.0
MOBA_BLOCK = 256
MOBA_TOPK = 3
MOBA_Q_CHUNK = 16
DIL_PATTERNS = ((128, 1), (512, 4), (2048, 16))
BAND_BLOCK = 128
D_FF = 3584
N_EXPERTS = 8
TOP_K = 2
MOE_ROW_BLOCK = 256
EPS = 1e-6

kernel_name = "hymba_fox_moba_dilated_moe"


def rmsnorm(x, g):
    xf = x.astype(jnp.float32)
    y = xf * lax.rsqrt(jnp.mean(xf * xf, axis=-1, keepdims=True) + EPS)
    return (y * g.astype(jnp.float32)).astype(x.dtype)


def rope_tables(seq):
    inv = ROPE_THETA ** (-jnp.arange(0, ROT_DIM, 2, dtype=jnp.float32) / ROT_DIM)
    ang = jnp.arange(seq, dtype=jnp.float32)[:, None] * inv[None, :]
    return jnp.cos(ang), jnp.sin(ang)


def partial_rope(x, cos, sin):
    half = ROT_DIM // 2
    c = cos.astype(x.dtype)
    s = sin.astype(x.dtype)
    x1 = x[..., :half]
    x2 = x[..., half:ROT_DIM]
    return jnp.concatenate([x1 * c - x2 * s, x2 * c + x1 * s, x[..., ROT_DIM:]], axis=-1)


def forgetting_attention(q, k, v, log_f):
    B, H, S, hd = q.shape
    c = jnp.cumsum(log_f, axis=-1)
    scale = hd ** -0.5
    outs = []
    for blk in range(S // Q_BLOCK):
        q0, q1 = blk * Q_BLOCK, (blk + 1) * Q_BLOCK
        logits = jnp.einsum('bhqd,bhkd->bhqk', q[:, :, q0:q1], k[:, :, :q1],
                            preferred_element_type=jnp.float32) * scale
        logits = logits + c[:, :, q0:q1, None] - c[:, :, None, :q1]
        causal = jnp.arange(q0, q1)[:, None] >= jnp.arange(q1)[None, :]
        p = jax.nn.softmax(jnp.where(causal, logits, -jnp.inf), axis=-1)
        outs.append(jnp.einsum('bhqk,bhkd->bhqd', p.astype(v.dtype), v[:, :, :q1]))
    return jnp.concatenate(outs, axis=2)


def moba_attention(q, k, v):
    B, H, S, hd = q.shape
    n_blk = -(-S // MOBA_BLOCK)
    Sp = n_blk * MOBA_BLOCK
    pad = ((0, 0), (0, 0), (0, Sp - S), (0, 0))
    qp, kp, vp = jnp.pad(q, pad), jnp.pad(k, pad), jnp.pad(v, pad)
    k_blocks = kp.reshape(B, H, n_blk, MOBA_BLOCK, hd)
    v_blocks = vp.reshape(B, H, n_blk, MOBA_BLOCK, hd)
    k_mean = jnp.mean(k_blocks.astype(jnp.float32), axis=3).astype(k.dtype)
    topk = min(MOBA_TOPK, n_blk)
    scale = hd ** -0.5
    b_idx = jnp.arange(B)[:, None, None, None]
    h_idx = jnp.arange(H)[None, :, None, None]

    def chunk(ci):
        q0 = ci * MOBA_Q_CHUNK
        qc = lax.dynamic_slice_in_dim(qp, q0, MOBA_Q_CHUNK, axis=2)
        own = q0 // MOBA_BLOCK
        gate = jnp.einsum('bhqd,bhnd->bhqn', qc, k_mean, preferred_element_type=jnp.float32)
        gate = jnp.where(jnp.arange(n_blk) < own, gate, -jnp.inf)
        _, gidx = lax.top_k(gate, topk)
        valid = gidx < own
        ksel = k_blocks[b_idx, h_idx, gidx]
        vsel = v_blocks[b_idx, h_idx, gidx]
        l_sel = jnp.einsum('bhqd,bhqjkd->bhqjk', qc, ksel, preferred_element_type=jnp.float32) * scale
        l_sel = jnp.where(valid[..., None], l_sel, -jnp.inf).reshape(B, H, MOBA_Q_CHUNK, topk * MOBA_BLOCK)
        kown = lax.dynamic_slice_in_dim(kp, own * MOBA_BLOCK, MOBA_BLOCK, axis=2)
        vown = lax.dynamic_slice_in_dim(vp, own * MOBA_BLOCK, MOBA_BLOCK, axis=2)
        l_own = jnp.einsum('bhqd,bhkd->bhqk', qc, kown, preferred_element_type=jnp.float32) * scale
        causal = (q0 + jnp.arange(MOBA_Q_CHUNK))[:, None] >= (own * MOBA_BLOCK + jnp.arange(MOBA_BLOCK))[None, :]
        l_own = jnp.where(causal, l_own, -jnp.inf)
        p = jax.nn.softmax(jnp.concatenate([l_sel, l_own], axis=-1), axis=-1).astype(v.dtype)
        p_sel = p[..., :topk * MOBA_BLOCK].reshape(B, H, MOBA_Q_CHUNK, topk, MOBA_BLOCK)
        p_own = p[..., topk * MOBA_BLOCK:]
        return (jnp.einsum('bhqjk,bhqjkd->bhqd', p_sel, vsel)
                + jnp.einsum('bhqk,bhkd->bhqd', p_own, vown))

    out = lax.map(chunk, jnp.arange(Sp // MOBA_Q_CHUNK))
    return jnp.moveaxis(out, 0, 2).reshape(B, H, Sp, hd)[:, :, :S]


def banded_causal_attention(q, k, v, span):
    *lead, L, hd = q.shape
    nb = -(-L // BAND_BLOCK)
    Lp = nb * BAND_BLOCK
    pad = [(0, 0)] * len(lead) + [(0, Lp - L), (0, 0)]

    def blocks(t):
        return jnp.pad(t, pad).reshape(*lead, nb, BAND_BLOCK, hd)

    def with_prev(t):
        prev = jnp.concatenate([jnp.zeros_like(t[..., :1, :, :]), t[..., :-1, :, :]], axis=-3)
        return jnp.concatenate([prev, t], axis=-2)

    qb = blocks(q)
    kw = with_prev(blocks(k))
    vw = with_prev(blocks(v))
    logits = jnp.einsum('...nqd,...nkd->...nqk', qb, kw, preferred_element_type=jnp.float32) * (hd ** -0.5)
    qpos = (jnp.arange(nb)[:, None] * BAND_BLOCK + jnp.arange(BAND_BLOCK)[None, :])[:, :, None]
    kpos = (jnp.arange(nb)[:, None] * BAND_BLOCK - BAND_BLOCK + jnp.arange(2 * BAND_BLOCK)[None, :])[:, None, :]
    dist = qpos - kpos
    mask = (dist >= 0) & (dist <= span) & (kpos >= 0)
    logits = jnp.where(mask, logits, -jnp.inf)
    lse = jax.nn.logsumexp(logits, axis=-1)
    p = jnp.exp(logits - lse[..., None]).astype(v.dtype)
    out = jnp.einsum('...nqk,...nkd->...nqd', p, vw)
    return out.reshape(*lead, Lp, hd)[..., :L, :], lse.reshape(*lead, Lp)[..., :L]


def dilated_attention(q, k, v):
    B, H, S, hd = q.shape
    outs, lses = [], []
    for window, dil in DIL_PATTERNS:
        L = S // dil

        def to_strided(t):
            return t.reshape(B, H, L, dil, hd).transpose(0, 1, 3, 2, 4)

        o, lse = banded_causal_attention(to_strided(q), to_strided(k), to_strided(v), window // dil)
        outs.append(o.transpose(0, 1, 3, 2, 4).reshape(B, H, S, hd))
        lses.append(lse.transpose(0, 1, 3, 2).reshape(B, H, S))
    w = jax.nn.softmax(jnp.stack(lses, axis=0), axis=0)
    acc = w[0][..., None].astype(q.dtype) * outs[0]
    for i in range(1, len(DIL_PATTERNS)):
        acc = acc + w[i][..., None].astype(q.dtype) * outs[i]
    return acc


def hybrid_mixer(h, w_in, b_f, mix_gain, w_out, cos, sin):
    B, S, _ = h.shape
    proj = h @ w_in
    qkv = proj[..., :3 * MIX_WIDTH].reshape(B, S, 3, N_HEADS, HEAD_DIM).transpose(2, 0, 3, 1, 4)
    q, k, v = qkv[0], qkv[1], qkv[2]
    f_logit = proj[..., 3 * MIX_WIDTH:].astype(jnp.float32) + b_f.astype(jnp.float32)
    log_f = jax.nn.log_sigmoid(f_logit).transpose(0, 2, 1)
    o_a = forgetting_attention(q[:, :H_FOX], k[:, :H_FOX], v[:, :H_FOX], log_f)
    q_r = partial_rope(q[:, H_FOX:], cos, sin)
    k_r = partial_rope(k[:, H_FOX:], cos, sin)
    o_b = moba_attention(q_r[:, :H_MOBA], k_r[:, :H_MOBA], v[:, H_FOX:H_FOX + H_MOBA])
    o_c = dilated_attention(q_r[:, H_MOBA:], k_r[:, H_MOBA:], v[:, H_FOX + H_MOBA:])
    wa, wb = H_FOX * HEAD_DIM, H_MOBA * HEAD_DIM
    ya = rmsnorm(o_a.transpose(0, 2, 1, 3).reshape(B, S, wa), mix_gain[:wa])
    yb = rmsnorm(o_b.transpose(0, 2, 1, 3).reshape(B, S, wb), mix_gain[wa:wa + wb])
    yc = rmsnorm(o_c.transpose(0, 2, 1, 3).reshape(B, S, H_DIL * HEAD_DIM), mix_gain[wa + wb:])
    return jnp.concatenate([ya, yb, yc], axis=-1) @ w_out


def swiglu(h, w1, w3, w2):
    return (jax.nn.silu(h @ w1) * (h @ w3)) @ w2


def moe_swiglu(h, w_router, we1, we3, we2):
    B, S, D = h.shape
    T = B * S
    x = h.reshape(T, D)
    logits = (x @ w_router).astype(jnp.float32)
    top_val, top_idx = lax.top_k(logits, TOP_K)
    gates = jax.nn.softmax(top_val, axis=-1)
    A = T * TOP_K
    expert = top_idx.reshape(A).astype(jnp.int32)
    token = jnp.repeat(jnp.arange(T, dtype=jnp.int32), TOP_K)
    gate = gates.reshape(A)
    order = jnp.argsort(expert)
    e_s, t_s, g_s = expert[order], token[order], gate[order]
    counts = jnp.bincount(expert, length=N_EXPERTS)
    padded = (counts + MOE_ROW_BLOCK - 1) // MOE_ROW_BLOCK * MOE_ROW_BLOCK
    starts = jnp.cumsum(counts) - counts
    pstarts = jnp.cumsum(padded) - padded
    dest = pstarts[e_s] + jnp.arange(A, dtype=jnp.int32) - starts[e_s]
    n_blocks = -(-(A + N_EXPERTS * (MOE_ROW_BLOCK - 1)) // MOE_ROW_BLOCK)
    n_rows = n_blocks * MOE_ROW_BLOCK
    row_token = jnp.full((n_rows,), T, jnp.int32).at[dest].set(t_s)
    row_gate = jnp.zeros((n_rows,), jnp.float32).at[dest].set(g_s)
    block_expert = jnp.minimum(
        jnp.searchsorted(jnp.cumsum(padded), jnp.arange(n_blocks) * MOE_ROW_BLOCK, side='right'),
        N_EXPERTS - 1)
    x_pad = jnp.concatenate([x, jnp.zeros((1, D), x.dtype)], axis=0)

    def body(y, inp):
        tok, g, e = inp
        xb = x_pad[tok]
        hid = jax.nn.silu(xb @ we1[e]) * (xb @ we3[e])
        return y.at[tok].add((hid @ we2[e]) * g[:, None].astype(xb.dtype)), None

    y, _ = lax.scan(body, jnp.zeros_like(x_pad),
                    (row_token.reshape(n_blocks, MOE_ROW_BLOCK),
                     row_gate.reshape(n_blocks, MOE_ROW_BLOCK), block_expert))
    return y[:T].reshape(B, S, D)


def setup_inputs(seed: int = 0) -> dict:
    key = jax.random.key(seed)
    ks = iter(jax.random.split(key, 64))

    def nrm(shape, scale):
        return jax.random.normal(next(ks), shape, jnp.float32) * scale

    def gain(n):
        return 1.0 + nrm((n,), 0.02)

    inp = {"x": nrm((BATCH, SEQ, D_MODEL), 1.0)}
    for l in range(DEPTH):
        p = "l%d_" % l
        inp[p + "norm_mix"] = gain(D_MODEL)
        inp[p + "w_in"] = nrm((D_MODEL, 3 * MIX_WIDTH + H_FOX), D_MODEL ** -0.5)
        inp[p + "b_f"] = FORGET_BIAS_INIT + nrm((H_FOX,), 0.5)
        inp[p + "mix_gain"] = gain(MIX_WIDTH)
        inp[p + "w_out"] = nrm((MIX_WIDTH, D_MODEL), MIX_WIDTH ** -0.5)
        inp[p + "norm_ffn"] = gain(D_MODEL)
        if l % 2 == 0:
            inp[p + "w1"] = nrm((D_MODEL, D_FF), D_MODEL ** -0.5)
            inp[p + "w3"] = nrm((D_MODEL, D_FF), D_MODEL ** -0.5)
            inp[p + "w2"] = nrm((D_FF, D_MODEL), D_FF ** -0.5)
        else:
            inp[p + "w_router"] = nrm((D_MODEL, N_EXPERTS), D_MODEL ** -0.5)
            inp[p + "we1"] = nrm((N_EXPERTS, D_MODEL, D_FF), D_MODEL ** -0.5)
            inp[p + "we3"] = nrm((N_EXPERTS, D_MODEL, D_FF), D_MODEL ** -0.5)
            inp[p + "we2"] = nrm((N_EXPERTS, D_FF, D_MODEL), D_FF ** -0.5)
    inp["final_norm"] = gain(D_MODEL)
    return inp


def reference(x, l0_norm_mix, l0_w_in, l0_b_f, l0_mix_gain, l0_w_out, l0_norm_ffn, l0_w1, l0_w3, l0_w2,
              l1_norm_mix, l1_w_in, l1_b_f, l1_mix_gain, l1_w_out, l1_norm_ffn,
              l1_w_router, l1_we1, l1_we3, l1_we2, final_norm):
    cos, sin = rope_tables(x.shape[1])
    mix_params = [(l0_norm_mix, l0_w_in, l0_b_f, l0_mix_gain, l0_w_out),
                  (l1_norm_mix, l1_w_in, l1_b_f, l1_mix_gain, l1_w_out)]
    ffn_norms = [l0_norm_ffn, l1_norm_ffn]
    ffn_params = [(l0_w1, l0_w3, l0_w2), (l1_w_router, l1_we1, l1_we3, l1_we2)]
    for i in range(DEPTH):
        g_mix, w_in, b_f, mix_gain, w_out = mix_params[i]
        x = x + hybrid_mixer(rmsnorm(x, g_mix), w_in, b_f, mix_gain, w_out, cos, sin)
        h = rmsnorm(x, ffn_norms[i])
        x = x + (swiglu(h, *ffn_params[i]) if i % 2 == 0 else moe_swiglu(h, *ffn_params[i]))
    return rmsnorm(x, final_norm)
```

```cpp
#include <hip/hip_runtime.h>
#include <hip/hip_bf16.h>
#include <cstdio>
#include <cstdint>
#include <cmath>
__device__ __forceinline__ int fresh_lane() { int l; asm volatile("v_mbcnt_lo_u32_b32 %0, -1, 0\n\tv_mbcnt_hi_u32_b32 %0, -1, %0" : "=v"(l)); return l; }
namespace pg8 {
#define PG8_LAS __attribute__((address_space(3)))
typedef unsigned short bf16_t;
typedef short bf16x8 __attribute__((ext_vector_type(8)));
typedef float f32x4 __attribute__((ext_vector_type(4)));
typedef unsigned u32x4 __attribute__((ext_vector_type(4)));
constexpr int BM = 256, BK = 64, HALF = 128, HTB = HALF * BK * 2  , STAGE_BYTES = 8 * HTB, NXCD = 8, WGM = 8;

__host__ __device__ __forceinline__ int lds_byte(int r, int c) { const int st = (r >> 4) * 2 + (c >> 5), rr = r & 15, cc = c & 31, ob = rr * 64 + cc * 2; return st * 1024 + (ob ^ (((ob >> 9) & 1) << 5)); }
__host__ __device__ __forceinline__ void stage_rc(int b, int& R, int& C) { const int st = b / 1024, sb = b % 1024, swz = sb ^ (((sb >> 9) & 1) << 5); R = (st >> 1) * 16 + swz / 64; C = (st & 1) * 32 + (swz % 64) / 2; }
__host__ __device__ __forceinline__ int perm32(int rho) { const int n = rho >> 4, i = rho & 15; return 8 * (i >> 2) + 4 * n + (i & 3); }

typedef int v8i32 __attribute__((ext_vector_type(8))); typedef int v4i32 __attribute__((ext_vector_type(4)));
__device__ __forceinline__ v8i32 pg8_cat(const bf16x8 lo, const bf16x8 hi) { const v4i32 a = __builtin_bit_cast(v4i32, lo), b = __builtin_bit_cast(v4i32, hi); return __builtin_shufflevector(a, b, 0, 1, 2, 3, 4, 5, 6, 7); }
template <int OFF> __device__ __forceinline__ void pg8_glds16(const char* sbase, unsigned voff, unsigned lds_base) { unsigned keep;
    asm volatile("s_mov_b32 %0, m0\n\ts_add_u32 m0, %3, %4\n\ts_nop 0\n\tglobal_load_lds_dwordx4 %1, %2\n\ts_mov_b32 m0, %0" : "=&s"(keep) : "v"(voff), "s"(sbase), "s"(lds_base), "i"(OFF) : "memory", "scc"); }
struct Unit { int pm, pn; };
struct Gemm { const bf16_t* A; const bf16_t* Bt; int M, N, K; };

struct StaticOrder {
    int nM, nN, nwg, G, c;
    __host__ __device__ void init(int M, int N, int G_, int c_) { nM = M / BM; nN = N / BM; nwg = nM * nN; G = G_; c = c_; }
    __host__ __device__ bool next(int i, Unit& u) const {
        const long L = (long)i * G + c; if (L >= nwg) return false;
        int wgid = (int)L; { const int q = nwg / NXCD, r = nwg % NXCD, xcd = wgid % NXCD, off = wgid / NXCD; wgid = (xcd < r ? xcd * (q + 1) : r * (q + 1) + (xcd - r) * q) + off; }
        const int nig = WGM * nN, gid = wgid / nig, fm = gid * WGM, gsz = (nM - fm) < WGM ? (nM - fm) : WGM;
        u.pm = fm + ((wgid % nig) % gsz); u.pn = (wgid % nig) / gsz; return true;
    }
    __device__ __forceinline__ size_t b_off(const Unit&) const { return 0; }
    __device__ __forceinline__ void a_ready(const Unit&) const {}
    __device__ __forceinline__ void done(const Unit&) const {}
};


typedef float f32x2 __attribute__((ext_vector_type(2)));
typedef __bf16 bf16x2_t __attribute__((ext_vector_type(2)));
__device__ __forceinline__ unsigned cvt_pk_bf16(float lo, float hi) { f32x2 v = {lo, hi}; bf16x2_t b = __builtin_convertvector(v, bf16x2_t); return __builtin_bit_cast(unsigned, b); }
__device__ __forceinline__ u32x4 pack8(const f32x4 v0, const f32x4 v1) { u32x4 w; w.x = cvt_pk_bf16(v0[0], v0[1]); w.y = cvt_pk_bf16(v0[2], v0[3]); w.z = cvt_pk_bf16(v1[0], v1[1]); w.w = cvt_pk_bf16(v1[2], v1[3]); return w; }

__device__ __forceinline__ float clamp448(float x) { return __builtin_fminf(__builtin_fmaxf(x, -448.f), 448.f); }
__device__ __forceinline__ unsigned cvt_fp8x4(float a, float b, float c, float d) { int w = __builtin_amdgcn_cvt_pk_fp8_f32(clamp448(a), clamp448(b), 0, false); w = __builtin_amdgcn_cvt_pk_fp8_f32(clamp448(c), clamp448(d), w, true); return (unsigned)w; }

struct EpiQKV {
    static constexpr bool PERM = true, AFTER_DRAIN = false;
    bf16_t* QKV; size_t tstride; const float* rcos; const float* rsin; float qscale; int rope_h0; int pn_off; int mode;
    __device__ __forceinline__ void operator()(const f32x4 (&acc)[2][2][4][2], const Unit& u, int wr, int wc, int fr, int fq) const {
        const int pnq = u.pn + pn_off, tsel = pnq >> 2, pq = pnq & 3;
        bf16_t* base = QKV + (size_t)tsel * tstride;
        const float sc = tsel == 0 ? qscale : 1.f;
        const int row0 = u.pm * BM + wr * 64 + fr, col0 = pq * BM + wc * 32 + 8 * fq;
        const bool ropew = (tsel < 2) && ((wc & 1) == 0) && (4 * pq + 2 + (wc >> 1) >= rope_h0) && !(mode & 2);
        const float pon = fq < 2 ? 1.f : 0.f, phase = (fq & 1) ? 0.f : 0.25f;
        constexpr float KF[8] = {1.591549431e-01f, 3.086376340e-02f, 5.985185713e-03f, 1.160663641e-03f, 2.250790790e-04f, 4.364795279e-05f, 8.464330808e-06f, 1.641426263e-06f};
#pragma unroll
        for (int ai = 0; ai < 2; ++ai)
#pragma unroll
            for (int m = 0; m < 4; ++m) {
                const int row = row0 + ai * HALF + m * 16;
                float ps[8], qc[8];
                if (ropew) { const float pf = (float)(row & 2047) * pon;
#pragma unroll
                    for (int j = 0; j < 8; ++j) { const float rev = __builtin_amdgcn_fractf(pf * KF[j] + phase); ps[j] = __builtin_amdgcn_sinf(rev); qc[j] = __builtin_amdgcn_cosf(rev); } }
                bf16_t* rowp = base + (size_t)row * 1024 + col0;
#pragma unroll
                for (int bj = 0; bj < 2; ++bj) {
                    f32x4 v0 = acc[ai][bj][m][0], v1 = acc[ai][bj][m][1];
                    const int head = 4 * pq + 2 * bj + (wc >> 1);
                    if (ropew && head >= rope_h0) {
#pragma unroll
                        for (int j = 0; j < 4; ++j) {
                            const unsigned a = __float_as_uint(v0[j]), b = __float_as_uint(v1[j]);
                            const auto ra = __builtin_amdgcn_permlane16_swap(a, a, false, false), rb = __builtin_amdgcn_permlane16_swap(b, b, false, false);
                            v0[j] = __uint_as_float(ra[0]) * ps[j] + __uint_as_float(ra[1]) * qc[j]; v1[j] = __uint_as_float(rb[0]) * ps[4 + j] + __uint_as_float(rb[1]) * qc[4 + j]; }
                    }
                    v0 = v0 * sc; v1 = v1 * sc;
                    if (!(mode & 1)) *(u32x4*)(rowp + bj * HALF) = pack8(v0, v1);
                }
            }
    }
};

template <bool BASE32> struct EpiRes {
    static constexpr bool PERM = true, AFTER_DRAIN = false;
    const void* base; bf16_t* out; int ldc;
    __device__ __forceinline__ void operator()(const f32x4 (&acc)[2][2][4][2], const Unit& u, int wr, int wc, int fr, int fq) const {
        const int row0 = u.pm * BM + wr * 64 + fr, col0 = u.pn * BM + wc * 32 + 8 * fq;
        constexpr int DEPTH = BASE32 ? 3 : 4;
        u32x4 b[DEPTH][BASE32 ? 4 : 2];
#define ER_OFF(g) ((size_t)(row0 + ((g) >> 2) * HALF + ((g) & 3) * 16) * ldc + col0)
#define ER_LOAD(g) do { if constexpr (BASE32) { const u32x4* bp = (const u32x4*)((const float*)base + ER_OFF(g)); b[(g) % DEPTH][0] = bp[0]; b[(g) % DEPTH][1] = bp[1]; b[(g) % DEPTH][2] = bp[HALF / 4]; b[(g) % DEPTH][3] = bp[HALF / 4 + 1]; } \
                        else { const bf16_t* bp = (const bf16_t*)base + ER_OFF(g); b[(g) % DEPTH][0] = *(const u32x4*)bp; b[(g) % DEPTH][1] = *(const u32x4*)(bp + HALF); } } while (0)
#pragma unroll
        for (int g = 0; g < DEPTH; ++g) ER_LOAD(g);
#pragma unroll
        for (int g = 0; g < 8; ++g) { const int ai = g >> 2, m = g & 3; u32x4 w[2];
#pragma unroll
            for (int bj = 0; bj < 2; ++bj) { f32x4 b0, b1;
                if constexpr (BASE32) { b0 = __builtin_bit_cast(f32x4, b[g % DEPTH][2 * bj]); b1 = __builtin_bit_cast(f32x4, b[g % DEPTH][2 * bj + 1]); }
                else { const u32x4 x = b[g % DEPTH][bj];
                    b0 = (f32x4){__uint_as_float(x.x << 16), __uint_as_float(x.x & 0xffff0000u), __uint_as_float(x.y << 16), __uint_as_float(x.y & 0xffff0000u)};
                    b1 = (f32x4){__uint_as_float(x.z << 16), __uint_as_float(x.z & 0xffff0000u), __uint_as_float(x.w << 16), __uint_as_float(x.w & 0xffff0000u)}; }
                w[bj] = pack8(b0 + acc[ai][bj][m][0], b1 + acc[ai][bj][m][1]); }
            asm volatile("" ::: "memory");
            *(u32x4*)(out + ER_OFF(g)) = w[0]; *(u32x4*)(out + ER_OFF(g) + HALF) = w[1];
            asm volatile("" ::: "memory");
            if (g + DEPTH < 8) ER_LOAD(g + DEPTH);
            asm volatile("" ::: "memory");
        }
#undef ER_LOAD
#undef ER_OFF
    }
};

template <bool OUT8> struct EpiSwiglu {
    static constexpr bool PERM = true, AFTER_DRAIN = false;
    void* H; int ldh; float hscale; int mode;
    __device__ __forceinline__ void hid(const f32x4 (&acc)[2][2][4][2], int ai, int m, f32x4 (&hv)[2]) const {
#pragma unroll
        for (int n = 0; n < 2; ++n) { const f32x4 g = acc[ai][0][m][n], up = acc[ai][1][m][n];
#pragma unroll
            for (int j = 0; j < 4; ++j) { if (mode & 2) hv[n][j] = g[j] + up[j]; else { const float e = __builtin_amdgcn_exp2f(-1.4426950408889634f * g[j]); hv[n][j] = g[j] * __builtin_amdgcn_rcpf(1.f + e) * up[j]; } } }
    }
    __device__ __forceinline__ void operator()(const f32x4 (&acc)[2][2][4][2], const Unit& u, int wr, int wc, int fr, int fq) const {
        const int row0 = u.pm * BM + wr * 64 + fr, col0 = u.pn * HALF + wc * 32 + 8 * fq;
        if constexpr (OUT8) {
            const int odd = fq & 1;
#pragma unroll
            for (int ai = 0; ai < 2; ++ai)
#pragma unroll
                for (int mp = 0; mp < 2; ++mp) {
                    f32x4 ha[2], hb[2]; hid(acc, ai, 2 * mp, ha); hid(acc, ai, 2 * mp + 1, hb);
                    const unsigned a0 = cvt_fp8x4(ha[0][0] * hscale, ha[0][1] * hscale, ha[0][2] * hscale, ha[0][3] * hscale), a1 = cvt_fp8x4(ha[1][0] * hscale, ha[1][1] * hscale, ha[1][2] * hscale, ha[1][3] * hscale);
                    const unsigned b0 = cvt_fp8x4(hb[0][0] * hscale, hb[0][1] * hscale, hb[0][2] * hscale, hb[0][3] * hscale), b1 = cvt_fp8x4(hb[1][0] * hscale, hb[1][1] * hscale, hb[1][2] * hscale, hb[1][3] * hscale);
                    const auto r0 = __builtin_amdgcn_permlane16_swap(a0, b0, false, false), r1 = __builtin_amdgcn_permlane16_swap(a1, b1, false, false);
                    u32x4 w; w.x = r0[0]; w.y = r1[0]; w.z = r0[1]; w.w = r1[1];
                    const size_t off = (size_t)(row0 + ai * HALF + (2 * mp + odd) * 16) * ldh + col0 - 8 * odd;
                    if (!(mode & 1)) *(u32x4*)((unsigned char*)H + off) = w;
                }
        } else {
#pragma unroll
            for (int ai = 0; ai < 2; ++ai)
#pragma unroll
                for (int m = 0; m < 4; ++m) { f32x4 hv[2]; hid(acc, ai, m, hv);
                    *(u32x4*)((bf16_t*)H + (size_t)(row0 + ai * HALF + m * 16) * ldh + col0) = pack8(hv[0], hv[1]); }
        }
    }
};

struct EpiY {
    static constexpr bool PERM = true, AFTER_DRAIN = false;
    unsigned char* Y; const float* gate; int row_base; float yscale;
    __device__ __forceinline__ void operator()(const f32x4 (&acc)[2][2][4][2], const Unit& u, int wr, int wc, int fr, int fq) const {
        const int row0 = row_base + u.pm * BM + wr * 64 + fr, col0 = u.pn * BM + wc * 32 + 8 * fq, odd = fq & 1;
        float gt[2][4];
#pragma unroll
        for (int ai = 0; ai < 2; ++ai)
#pragma unroll
            for (int m = 0; m < 4; ++m) gt[ai][m] = gate[row0 + ai * HALF + m * 16];
        asm volatile("" ::: "memory");
#pragma unroll
        for (int ai = 0; ai < 2; ++ai)
#pragma unroll
            for (int mp = 0; mp < 2; ++mp) { const int rowA = row0 + ai * HALF + (2 * mp) * 16, rowB = rowA + 16; const float ga = gt[ai][2 * mp] * yscale, gb = gt[ai][2 * mp + 1] * yscale;
                unsigned char* rowp = Y + (size_t)(odd ? rowB : rowA) * 1024 + col0 - 8 * odd;
#pragma unroll
                for (int bj = 0; bj < 2; ++bj) { const f32x4 a0v = acc[ai][bj][2 * mp][0] * ga, a1v = acc[ai][bj][2 * mp][1] * ga, b0v = acc[ai][bj][2 * mp + 1][0] * gb, b1v = acc[ai][bj][2 * mp + 1][1] * gb;
                    const unsigned a0 = cvt_fp8x4(a0v[0], a0v[1], a0v[2], a0v[3]), a1 = cvt_fp8x4(a1v[0], a1v[1], a1v[2], a1v[3]), b0 = cvt_fp8x4(b0v[0], b0v[1], b0v[2], b0v[3]), b1 = cvt_fp8x4(b1v[0], b1v[1], b1v[2], b1v[3]);
                    const auto r0 = __builtin_amdgcn_permlane16_swap(a0, b0, false, false), r1 = __builtin_amdgcn_permlane16_swap(a1, b1, false, false);
                    u32x4 w; w.x = r0[0]; w.y = r1[0]; w.z = r0[1]; w.w = r1[1];
                    *(u32x4*)(rowp + bj * HALF) = w; } }
    }
};

struct MoeOrder : StaticOrder {
    const PG8_LAS int* be_lds; size_t estride;
    __device__ __forceinline__ size_t b_off(const Unit& u) const { return (size_t)__builtin_amdgcn_readfirstlane(be_lds[u.pm]) * estride; }
};
template <class Epi, class Sched, bool ALIGN_EPI = false, bool SP2 = false, bool FP8 = false>
__device__ __forceinline__ void gemm_phase(PG8_LAS unsigned char* lds, const Gemm g, const Sched& S, const Epi& E, const int wave_id, const int sexp = 127) {
    const int wid = wave_id, tid = wave_id * 64 + fresh_lane(), lane = tid & 63, wr = wid >> 2, wc = wid & 3, fr = lane & 15, fq = lane >> 4;
    const int K = g.K, nt = K / BK; const int sexp_v = sexp * 0x01010101;
    unsigned voffA[2], voffB[2];
#pragma unroll
    for (int i = 0; i < 2; ++i) { int R, C; stage_rc(tid * 16 + i * 8192, R, C); const int Rb = Epi::PERM ? ((R & ~31) + perm32(R & 31)) : R;
        voffA[i] = (unsigned)(R * K + C) * 2u; voffB[i] = (unsigned)(Rb * K + C) * 2u; }
    const size_t kstep = (size_t)(BK * 2);
    const size_t hstep = (size_t)HALF * K * 2;
    const size_t tstep = 2 * hstep;
    const unsigned lds_wave = (unsigned)__builtin_amdgcn_readfirstlane((unsigned)(uintptr_t)lds + (unsigned)wid * 1024u); const unsigned ldsw = (unsigned)wid * 1024u;
    const int aoff = lds_byte(wr * 64 + fr, fq * 8), boff = lds_byte(wc * 32 + fr, fq * 8);
#define PG8_SA(b, h) (((b) * 2 + (h)) * HTB)
#define PG8_SB(b, h) ((4 + (b) * 2 + (h)) * HTB)
#define PG8_STAGE(bufoff, gbase, voff) do { if constexpr (FP8) { pg8_glds16<(bufoff)>((const char*)(gbase), (voff)[0], lds_wave); pg8_glds16<(bufoff) + 8192>((const char*)(gbase), (voff)[1], lds_wave); } \
        else { _Pragma("unroll") for (int _i = 0; _i < 2; ++_i) __builtin_amdgcn_global_load_lds((const unsigned*)((const char*)(gbase) + (voff)[_i]), (PG8_LAS unsigned*)(lds + (bufoff) + ldsw + _i * 8192), 16, 0, 0); } } while (0)
#define PG8_LDA(dst, b, h) do { if constexpr (FP8) { _Pragma("unroll") for (int m = 0; m < 4; ++m) { const v4i32 lo_ = *(const PG8_LAS v4i32*)(lds + PG8_SA(b, h) + aoff + m * 2048), hi_ = *(const PG8_LAS v4i32*)(lds + PG8_SA(b, h) + aoff + m * 2048 + 1024); dst##8[m] = __builtin_shufflevector(lo_, hi_, 0, 1, 2, 3, 4, 5, 6, 7); } } else { \
        _Pragma("unroll") for (int m = 0; m < 4; ++m) _Pragma("unroll") for (int k = 0; k < 2; ++k) dst[m][k] = *(const PG8_LAS bf16x8*)(lds + PG8_SA(b, h) + aoff + m * 2048 + k * 1024); } } while (0)
#define PG8_LDB(dst, b, h) do { if constexpr (FP8) { _Pragma("unroll") for (int n = 0; n < 2; ++n) { const v4i32 lo_ = *(const PG8_LAS v4i32*)(lds + PG8_SB(b, h) + boff + n * 2048), hi_ = *(const PG8_LAS v4i32*)(lds + PG8_SB(b, h) + boff + n * 2048 + 1024); dst##8[n] = __builtin_shufflevector(lo_, hi_, 0, 1, 2, 3, 4, 5, 6, 7); } } else { \
        _Pragma("unroll") for (int n = 0; n < 2; ++n) _Pragma("unroll") for (int k = 0; k < 2; ++k) dst[n][k] = *(const PG8_LAS bf16x8*)(lds + PG8_SB(b, h) + boff + n * 2048 + k * 1024); } } while (0)
#define PG8_MMA(ai, bj, At, Bt) do { __builtin_amdgcn_s_setprio(1); if constexpr (FP8) { _Pragma("unroll") for (int m = 0; m < 4; ++m) _Pragma("unroll") for (int n = 0; n < 2; ++n) \
        acc[ai][bj][m][n] = __builtin_amdgcn_mfma_scale_f32_16x16x128_f8f6f4(Bt##8[n], At##8[m], acc[ai][bj][m][n], 0, 0, 0, sexp_v, 0, 0x7f7f7f7f); } else { \
        _Pragma("unroll") for (int m = 0; m < 4; ++m) _Pragma("unroll") for (int n = 0; n < 2; ++n) _Pragma("unroll") for (int k = 0; k < 2; ++k) \
        acc[ai][bj][m][n] = __builtin_amdgcn_mfma_f32_16x16x32_bf16(Bt[n][k], At[m][k], acc[ai][bj][m][n], 0, 0, 0); } __builtin_amdgcn_s_setprio(0); } while (0)
#define PG8_WAIT_V(n) asm volatile("s_waitcnt vmcnt(" #n ")" ::: "memory")
#define PG8_WAIT_L(n) asm volatile("s_waitcnt lgkmcnt(" #n ")" ::: "memory")
#define PG8_BAR __builtin_amdgcn_s_barrier()
#define PG8_SCHED __builtin_amdgcn_sched_barrier(0)
    Unit cur, nxt; int ui = 0;
    if (!S.next(0, cur)) return;
    f32x4 acc[2][2][4][2];
#pragma unroll
    for (int a = 0; a < 2; ++a)
#pragma unroll
        for (int b = 0; b < 2; ++b)
#pragma unroll
            for (int m = 0; m < 4; ++m)
#pragma unroll
                for (int n = 0; n < 2; ++n) acc[a][b][m][n] = (f32x4){0.f, 0.f, 0.f, 0.f};
    bf16x8 At[4][2], B0[2][2], B1[2][2]; v8i32 At8[4], B08[2], B18[2];
    const char* cA = (const char*)g.A + (size_t)cur.pm * tstep; const char* cB = (const char*)g.Bt + S.b_off(cur) + (size_t)cur.pn * tstep;
    S.a_ready(cur);
    if constexpr (SP2) {
        PG8_STAGE(PG8_SB(0, 0), cB, voffB); PG8_STAGE(PG8_SB(0, 1), cB + hstep, voffB); PG8_STAGE(PG8_SA(0, 0), cA, voffA); PG8_STAGE(PG8_SA(0, 1), cA + hstep, voffA);
        if (wr == 1) PG8_BAR;
        PG8_WAIT_V(2); PG8_BAR;
        PG8_STAGE(PG8_SB(1, 0), cB + kstep, voffB); PG8_STAGE(PG8_SA(1, 0), cA + kstep, voffA); PG8_STAGE(PG8_SB(1, 1), cB + hstep + kstep, voffB);
        PG8_WAIT_V(6); PG8_BAR;
    } else {
        PG8_STAGE(PG8_SB(0, 0), cB, voffB); PG8_STAGE(PG8_SA(0, 0), cA, voffA); PG8_STAGE(PG8_SB(0, 1), cB + hstep, voffB); PG8_STAGE(PG8_SA(0, 1), cA + hstep, voffA);
        if (wr == 1) PG8_BAR;
        PG8_WAIT_V(4); PG8_BAR;
        PG8_STAGE(PG8_SB(1, 0), cB + kstep, voffB); PG8_STAGE(PG8_SA(1, 0), cA + kstep, voffA); PG8_STAGE(PG8_SB(1, 1), cB + hstep + kstep, voffB);
        PG8_WAIT_V(6); PG8_BAR;
    }
    for (;;) {
        const bool has_next = S.next(ui + 1, nxt);
        const char* nA = has_next ? (const char*)g.A + (size_t)nxt.pm * tstep : cA; const char* nB = has_next ? (const char*)g.Bt + S.b_off(nxt) + (size_t)nxt.pn * tstep : cB;
#pragma unroll 1
        for (int t = 0; t < nt; t += 2) {
            const bool last = (t == nt - 2);
            const char* a1 = cA + (size_t)(t + 1) * kstep;
            const char* a2 = last ? nA : cA + (size_t)(t + 2) * kstep; const char* b2 = last ? nB : cB + (size_t)(t + 2) * kstep;
            const char* a3 = a2 + kstep; const char* b3 = b2 + kstep;
            if (last && has_next) S.a_ready(nxt);
            if constexpr (SP2) {
            PG8_LDB(B0, 0, 0); PG8_LDB(B1, 0, 1); PG8_SCHED; PG8_LDA(At, 0, 0); PG8_STAGE(PG8_SA(1, 1), a1 + hstep, voffA);
            PG8_WAIT_V(8); PG8_WAIT_L(0); PG8_BAR; PG8_MMA(0, 0, At, B0); PG8_MMA(0, 1, At, B1); PG8_BAR; PG8_SCHED;
            PG8_LDA(At, 0, 1); PG8_STAGE(PG8_SB(0, 0), b2, voffB); PG8_STAGE(PG8_SB(0, 1), b2 + hstep, voffB); PG8_STAGE(PG8_SA(0, 0), a2, voffA);
            PG8_WAIT_V(8); PG8_WAIT_L(0); PG8_BAR; PG8_MMA(1, 0, At, B0); PG8_MMA(1, 1, At, B1); PG8_BAR; PG8_SCHED;
            PG8_LDB(B0, 1, 0); PG8_LDB(B1, 1, 1); PG8_SCHED; PG8_LDA(At, 1, 0); PG8_STAGE(PG8_SA(0, 1), a2 + hstep, voffA);
            PG8_WAIT_V(8); PG8_WAIT_L(0); PG8_BAR; PG8_MMA(0, 0, At, B0); PG8_MMA(0, 1, At, B1); PG8_BAR; PG8_SCHED;
            PG8_LDA(At, 1, 1); PG8_STAGE(PG8_SB(1, 0), b3, voffB); PG8_STAGE(PG8_SB(1, 1), b3 + hstep, voffB); PG8_STAGE(PG8_SA(1, 0), a3, voffA);
            PG8_WAIT_V(8); PG8_WAIT_L(0); PG8_BAR; PG8_MMA(1, 0, At, B0); PG8_MMA(1, 1, At, B1); PG8_BAR; PG8_SCHED;
            } else {
            PG8_LDB(B0, 0, 0); PG8_SCHED; PG8_LDA(At, 0, 0); PG8_STAGE(PG8_SA(1, 1), a1 + hstep, voffA);
            PG8_WAIT_L(8); PG8_BAR; PG8_WAIT_L(0); PG8_MMA(0, 0, At, B0); PG8_BAR; PG8_SCHED;
            PG8_LDB(B1, 0, 1); PG8_STAGE(PG8_SB(0, 0), b2, voffB);
            PG8_BAR; PG8_WAIT_L(0); PG8_MMA(0, 1, At, B1); PG8_BAR;
            PG8_LDA(At, 0, 1); PG8_STAGE(PG8_SA(0, 0), a2, voffA);
            PG8_BAR; PG8_WAIT_L(0); PG8_MMA(1, 0, At, B0); PG8_BAR; PG8_SCHED;
            PG8_STAGE(PG8_SB(0, 1), b2 + hstep, voffB);
            PG8_WAIT_V(6); PG8_BAR; PG8_MMA(1, 1, At, B1); PG8_BAR;
            PG8_LDB(B0, 1, 0); PG8_SCHED; PG8_LDA(At, 1, 0); PG8_STAGE(PG8_SA(0, 1), a2 + hstep, voffA);
            PG8_WAIT_L(8); PG8_BAR; PG8_WAIT_L(0); PG8_MMA(0, 0, At, B0); PG8_BAR; PG8_SCHED;
            PG8_LDB(B1, 1, 1); PG8_STAGE(PG8_SB(1, 0), b3, voffB);
            PG8_BAR; PG8_WAIT_L(0); PG8_MMA(0, 1, At, B1); PG8_BAR;
            PG8_LDA(At, 1, 1); PG8_STAGE(PG8_SA(1, 0), a3, voffA);
            PG8_BAR; PG8_WAIT_L(0); PG8_MMA(1, 0, At, B0); PG8_BAR; PG8_SCHED;
            PG8_STAGE(PG8_SB(1, 1), b3 + hstep, voffB);
            PG8_WAIT_V(6); PG8_BAR; PG8_MMA(1, 1, At, B1); PG8_BAR;
            }
        }
        if constexpr (ALIGN_EPI) { if (wr == 0) PG8_BAR; }
        if constexpr (!Epi::AFTER_DRAIN) { const int lane_e = fresh_lane();
            E(acc, cur, wr, wc, lane_e & 15, lane_e >> 4); S.done(cur); }
        if (!has_next) break;
#pragma unroll
        for (int a = 0; a < 2; ++a)
#pragma unroll
            for (int b = 0; b < 2; ++b)
#pragma unroll
                for (int m = 0; m < 4; ++m)
#pragma unroll
                    for (int n = 0; n < 2; ++n) acc[a][b][m][n] = (f32x4){0.f, 0.f, 0.f, 0.f};
        cur = nxt; cA = nA; cB = nB; ++ui;
        if constexpr (ALIGN_EPI) { if (wr == 1) PG8_BAR; }
    }
    PG8_WAIT_V(0);
    if constexpr (!ALIGN_EPI) { if (wr == 0) PG8_BAR; }
    PG8_BAR;
    if constexpr (Epi::AFTER_DRAIN) { E.fused(acc, cur, wr, wc, fr, fq, lds, wid, lane); S.done(cur); }
#undef PG8_SA
#undef PG8_SB
#undef PG8_STAGE
#undef PG8_LDA
#undef PG8_LDB
#undef PG8_MMA
#undef PG8_WAIT_V
#undef PG8_WAIT_L
#undef PG8_BAR
#undef PG8_SCHED
}
}

namespace att {
#define ATT_LAS __attribute__((address_space(3)))
using bf16x8 = __attribute__((ext_vector_type(8))) short;
using s16x4 = __attribute__((ext_vector_type(4))) short;
using f32x16 = __attribute__((ext_vector_type(16))) float;
using u32x4 = __attribute__((ext_vector_type(4))) unsigned;
typedef short v4i16_t __attribute__((ext_vector_type(4)));
typedef unsigned short bf16;
constexpr int SEQ = 2048, PITCH = 1024, NTOK = 32 * 2048;
constexpr int KSLOT = 9216, VSLOT = 8192;
constexpr int NSLOT = 3;
constexpr int L_K = 0, L_V = NSLOT * 2 * KSLOT, L_WS = L_V + NSLOT * 2 * VSLOT, L_OST = 0  , L_BYTES = L_WS + 8 * 256;
constexpr int LD_K = 0, LD_V = 6 * 8192, LD_WS = 12 * 8192, LD_OST = LD_WS + 8 * 256, LD_BYTES = LD_OST + 8 * 4096;
constexpr float C2 = 0.125f * 1.4426950408889634f;
constexpr float THR = 8.f;
enum { T_FOX = 0, T_MOBA = 1, T_D1 = 2, T_D4 = 3, T_D16 = 4 };
struct Tens { const bf16* Q; const bf16* K; const bf16* V; bf16* O; bf16* OX1; bf16* OX2; float* LSE; const u32x4* KAUG; const float* KMEAN; int mode; };

__device__ __forceinline__ int crow(int r, int hi) { return (r & 3) + 8 * (r >> 2) + 4 * hi; }
__device__ __forceinline__ void glds16s(const void* sbase, unsigned voff, unsigned lds_dst) { unsigned keep;
    asm volatile("s_mov_b32 %0, m0\n\ts_mov_b32 m0, %3\n\ts_nop 0\n\tglobal_load_lds_dwordx4 %1, %2\n\ts_mov_b32 m0, %0" : "=&s"(keep) : "v"(voff), "s"(sbase), "s"(lds_dst) : "memory"); }
typedef float f32x2_t __attribute__((ext_vector_type(2))); typedef __bf16 bf16x2_t __attribute__((ext_vector_type(2)));
__device__ __forceinline__ unsigned cvtpk_s(float lo, float hi) { f32x2_t v = {lo, hi}; bf16x2_t b = __builtin_convertvector(v, bf16x2_t); return __builtin_bit_cast(unsigned, b); }
__device__ __forceinline__ s16x4 vtr(const ATT_LAS char* p) { return __builtin_bit_cast(s16x4, __builtin_amdgcn_ds_read_tr16_b64_v4i16((ATT_LAS v4i16_t*)p)); }
#define ATT_MX3(a, b, c) __builtin_fmaxf(__builtin_fmaxf((a), (b)), (c))

template <bool AUG> __device__ __forceinline__ void qk_tile(f32x16& p0, f32x16& p1, const ATT_LAS char* kslot, const bf16x8 (&qr)[4], const f32x16& cinit, int r32, int hi) {
    const ATT_LAS char* kp = kslot + hi * 1024 + r32 * 16;
#pragma unroll
    for (int d0 = 0; d0 < 4; ++d0) {
        const bf16x8 b0 = *(const ATT_LAS bf16x8*)(kp + d0 * 2048), b1 = *(const ATT_LAS bf16x8*)(kp + d0 * 2048 + 512);
        if (d0 == 0) { p0 = __builtin_amdgcn_mfma_f32_32x32x16_bf16(b0, qr[0], cinit, 0, 0, 0); p1 = __builtin_amdgcn_mfma_f32_32x32x16_bf16(b1, qr[0], cinit, 0, 0, 0); }
        else { p0 = __builtin_amdgcn_mfma_f32_32x32x16_bf16(b0, qr[d0], p0, 0, 0, 0); p1 = __builtin_amdgcn_mfma_f32_32x32x16_bf16(b1, qr[d0], p1, 0, 0, 0); }
    }
    if (AUG) { const ATT_LAS char* ka = kslot + 8192 + r32 * 16;
        const bf16x8 a0_ = *(const ATT_LAS bf16x8*)(ka), a1_ = *(const ATT_LAS bf16x8*)(ka + 512);
        const short one = hi == 0 ? (short)0x3f80 : (short)0; const bf16x8 qaug = {one, one, one, 0, 0, 0, 0, 0};
        p0 = __builtin_amdgcn_mfma_f32_32x32x16_bf16(a0_, qaug, p0, 0, 0, 0); p1 = __builtin_amdgcn_mfma_f32_32x32x16_bf16(a1_, qaug, p1, 0, 0, 0); }
}
__device__ __forceinline__ void exp_pack(f32x16& p0, f32x16& p1, u32x4 (&pw)[4], float& l_reg) {
    float s0 = 0.f, s1 = 0.f;
#pragma unroll
    for (int r = 0; r < 16; ++r) { p0[r] = __builtin_amdgcn_exp2f(p0[r]); p1[r] = __builtin_amdgcn_exp2f(p1[r]); s0 += p0[r]; asm volatile("" : "+v"(s0)); s1 += p1[r]; asm volatile("" : "+v"(s1)); }
    l_reg += s0 + s1;
#pragma unroll
    for (int k = 0; k < 4; ++k) { pw[0][k] = cvtpk_s(p0[2 * k], p0[2 * k + 1]); pw[1][k] = cvtpk_s(p0[8 + 2 * k], p0[9 + 2 * k]); pw[2][k] = cvtpk_s(p1[2 * k], p1[2 * k + 1]); pw[3][k] = cvtpk_s(p1[8 + 2 * k], p1[9 + 2 * k]); }
}
__device__ __forceinline__ void pv_tile(f32x16 (&o)[2], const u32x4 (&pw)[4], const ATT_LAS char* vp) {
#pragma unroll
    for (int d0 = 0; d0 < 2; ++d0)
#pragma unroll
        for (int ks = 0; ks < 4; ++ks) { const s16x4 lo = vtr(vp + d0 * 4096 + ks * 1024), hh = vtr(vp + d0 * 4096 + ks * 1024 + 512);
            const bf16x8 vf = {lo[0], lo[1], lo[2], lo[3], hh[0], hh[1], hh[2], hh[3]};
            o[d0] = __builtin_amdgcn_mfma_f32_32x32x16_bf16(__builtin_bit_cast(bf16x8, pw[ks]), vf, o[d0], 0, 0, 0); }
}
struct St { float mhat, l_reg; f32x16 o[2]; f32x16 negm; u32x4 pw[4]; const ATT_LAS char* vprev; bool pend; };
__device__ __forceinline__ void st_init(St& s) { s.mhat = 0.f; s.l_reg = 0.f; s.o[0] = f32x16{}; s.o[1] = f32x16{}; s.negm = f32x16{}; s.vprev = nullptr; s.pend = false;
#pragma unroll
    for (int k = 0; k < 4; ++k) s.pw[k] = u32x4{0u, 0u, 0u, 0u}; }
template <bool AUG> __device__ __forceinline__ void tile_step(St& s, const ATT_LAS char* kslot, const ATT_LAS char* vslot_l, const bf16x8 (&qr)[4], bool lanesel, bool on, bool hi_act, bool lo_act, int dq,
                                                              ATT_LAS float* wsf, int r32, int hi, const int mode = 0) {
    f32x16 p0, p1;
    if (mode & 128) { p0 = s.negm; p1 = s.negm; }
    else if (lanesel && !__all(on)) { f32x16 cm;
#pragma unroll
        for (int r = 0; r < 16; ++r) cm[r] = on ? s.negm[r] : -INFINITY;
        qk_tile<AUG>(p0, p1, kslot, qr, cm, r32, hi); }
    else qk_tile<AUG>(p0, p1, kslot, qr, s.negm, r32, hi);
    if (s.pend && !(mode & 16)) pv_tile(s.o, s.pw, s.vprev);
    if (hi_act) {
#pragma unroll
        for (int r = 0; r < 16; ++r) { const int c = (r & 3) + 8 * (r >> 2); if (c > dq) p0[r] = -INFINITY; if (c + 32 > dq) p1[r] = -INFINITY; } }
    if (lo_act) { const int dl_ = dq - 128;
#pragma unroll
        for (int r = 0; r < 16; ++r) { const int c = (r & 3) + 8 * (r >> 2); if (c < dl_) p0[r] = -INFINITY; if (c + 32 < dl_) p1[r] = -INFINITY; } }
    float a = ATT_MX3(p0[0], p0[1], p1[0]), bq = ATT_MX3(p0[2], p0[3], p1[1]); a = ATT_MX3(a, p1[2], p1[3]);
#pragma unroll
    for (int r = 4; r < 16; r += 4) { a = ATT_MX3(a, p0[r], p0[r + 1]); bq = ATT_MX3(bq, p0[r + 2], p0[r + 3]); a = ATT_MX3(a, p1[r], p1[r + 1]); bq = ATT_MX3(bq, p1[r + 2], p1[r + 3]); }
    float rm = (mode & 64) ? 0.f : __builtin_fmaxf(a, bq);
    { auto rr = __builtin_amdgcn_permlane32_swap(__float_as_uint(rm), __float_as_uint(rm), false, false); rm = __builtin_fmaxf(__uint_as_float(rr[0]), __uint_as_float(rr[1])); }
    if (__any(rm > THR)) { const float dl = __builtin_fmaxf(rm, 0.f); s.mhat += dl;
#pragma unroll
        for (int r = 0; r < 16; ++r) { p0[r] -= dl; p1[r] -= dl; s.negm[r] = -s.mhat; }
        const float f = __builtin_amdgcn_exp2f(-dl); s.l_reg *= f; if (hi == 0) wsf[r32] = f;
#pragma unroll
        for (int r = 0; r < 16; ++r) { const float fr_ = wsf[crow(r, hi)]; s.o[0][r] *= fr_; s.o[1][r] *= fr_; } }
    if (!(mode & 8)) exp_pack(p0, p1, s.pw, s.l_reg); else { s.l_reg += p0[0] + p1[5]; }
    s.pend = true; s.vprev = vslot_l;
}
template <bool AUG, bool SEL> __device__ __forceinline__ void tile_step_steady(St& s, const ATT_LAS char* kslot, const ATT_LAS char* vslot_l, const bf16x8 (&qr)[4], bool on, ATT_LAS float* wsf, int r32, int hi,
                                                                        const bool hi_act = false, const bool lo_act = false, const int dq = 0) {
    f32x16 p0, p1;
    __builtin_amdgcn_s_setprio(1);
    if (SEL) { f32x16 cm;
#pragma unroll
        for (int r = 0; r < 16; ++r) cm[r] = on ? s.negm[r] : -INFINITY;
        qk_tile<AUG>(p0, p1, kslot, qr, cm, r32, hi); }
    else qk_tile<AUG>(p0, p1, kslot, qr, s.negm, r32, hi);
    __builtin_amdgcn_s_setprio(0);
    if (hi_act) {
#pragma unroll
        for (int r = 0; r < 16; ++r) { const int c = (r & 3) + 8 * (r >> 2); if (c > dq) p0[r] = -INFINITY; if (c + 32 > dq) p1[r] = -INFINITY; } }
    if (lo_act) { const int dl_ = dq - 128;
#pragma unroll
        for (int r = 0; r < 16; ++r) { const int c = (r & 3) + 8 * (r >> 2); if (c < dl_) p0[r] = -INFINITY; if (c + 32 < dl_) p1[r] = -INFINITY; } }
    float a = ATT_MX3(p0[0], p0[1], p1[0]), bq = ATT_MX3(p0[2], p0[3], p1[1]); a = ATT_MX3(a, p1[2], p1[3]);
#pragma unroll
    for (int r = 4; r < 16; r += 4) { a = ATT_MX3(a, p0[r], p0[r + 1]); bq = ATT_MX3(bq, p0[r + 2], p0[r + 3]); a = ATT_MX3(a, p1[r], p1[r + 1]); bq = ATT_MX3(bq, p1[r + 2], p1[r + 3]); }
    float rm = __builtin_fmaxf(a, bq);
    { auto rr = __builtin_amdgcn_permlane32_swap(__float_as_uint(rm), __float_as_uint(rm), false, false); rm = __builtin_fmaxf(__uint_as_float(rr[0]), __uint_as_float(rr[1])); }
    const bool resc = __any(rm > THR);
    if (__builtin_expect(resc, 0)) { const float dl = __builtin_fmaxf(rm, 0.f); s.mhat += dl;
#pragma unroll
        for (int r = 0; r < 16; ++r) { p0[r] -= dl; p1[r] -= dl; s.negm[r] = -s.mhat; }
        const float f = __builtin_amdgcn_exp2f(-dl); s.l_reg *= f; if (hi == 0) wsf[r32] = f; }
    const ATT_LAS char* vp = s.vprev;
    s16x4 vlo = vtr(vp), vhi = vtr(vp + 512);
    float s0 = 0.f, s1 = 0.f;
    __builtin_amdgcn_sched_barrier(0);
#pragma unroll
    for (int i = 0; i < 8; ++i) {
        s16x4 nlo = vlo, nhi = vhi;
        if (i < 7) { const int off = ((i + 1) >> 2) * 4096 + ((i + 1) & 3) * 1024; nlo = vtr(vp + off); nhi = vtr(vp + off + 512); }
        const bf16x8 vf = {vlo[0], vlo[1], vlo[2], vlo[3], vhi[0], vhi[1], vhi[2], vhi[3]};
        s.o[i >> 2] = __builtin_amdgcn_mfma_f32_32x32x16_bf16(__builtin_bit_cast(bf16x8, s.pw[i & 3]), vf, s.o[i >> 2], 0, 0, 0);
        if (i < 4) {
#pragma unroll
            for (int j = 0; j < 4; ++j) { p0[4 * i + j] = __builtin_amdgcn_exp2f(p0[4 * i + j]); s0 += p0[4 * i + j]; }
            asm volatile("" : "+v"(s0), "+v"(p0));
        } else {
#pragma unroll
            for (int j = 0; j < 4; ++j) { p1[4 * (i - 4) + j] = __builtin_amdgcn_exp2f(p1[4 * (i - 4) + j]); s1 += p1[4 * (i - 4) + j]; }
            asm volatile("" : "+v"(s1), "+v"(p1));
        }
        __builtin_amdgcn_sched_barrier(0);
        vlo = nlo; vhi = nhi;
    }
#pragma unroll
    for (int r = 0; r < 16; ++r) {   }
    s.l_reg += s0 + s1;
    if (__builtin_expect(resc, 0)) {
#pragma unroll
        for (int r = 0; r < 16; ++r) { const float fr_ = wsf[crow(r, hi)]; s.o[0][r] *= fr_; s.o[1][r] *= fr_; } }
#pragma unroll
    for (int k = 0; k < 4; ++k) { s.pw[0][k] = cvtpk_s(p0[2 * k], p0[2 * k + 1]); s.pw[1][k] = cvtpk_s(p0[8 + 2 * k], p0[9 + 2 * k]); s.pw[2][k] = cvtpk_s(p1[2 * k], p1[2 * k + 1]); s.pw[3][k] = cvtpk_s(p1[8 + 2 * k], p1[9 + 2 * k]); }
    s.vprev = vslot_l;
}
__device__ __forceinline__ void unit_finish(St& s, ATT_LAS float* wsf, ATT_LAS bf16* stg, bf16* Ob, int opitch, int qrow0, int kstr, float* lse_dst, int lane, int r32, int hi, const int mode) {
    if (s.pend) pv_tile(s.o, s.pw, s.vprev);
    float l_reg = s.l_reg;
    { auto rr = __builtin_amdgcn_permlane32_swap(__float_as_uint(l_reg), __float_as_uint(l_reg), false, false); l_reg = __uint_as_float(rr[0]) + __uint_as_float(rr[1]); }
    if (hi == 0) wsf[32 + r32] = l_reg;
    if (lse_dst != nullptr && hi == 0 && !(mode & 1)) *lse_dst = s.mhat + __builtin_amdgcn_logf(l_reg);
#pragma unroll
    for (int r = 0; r < 16; ++r) { const int orow = crow(r, hi); const float rl = __builtin_amdgcn_rcpf(wsf[32 + orow]);
        const unsigned w = cvtpk_s(s.o[0][r] * rl, s.o[1][r] * rl);
        stg[orow * 64 + r32] = (bf16)(w & 0xffffu); stg[orow * 64 + 32 + r32] = (bf16)(w >> 16); }
#pragma unroll
    for (int i = 0; i < 4; ++i) { const int row = i * 8 + (lane >> 3), ch = lane & 7; const u32x4 v = *(const ATT_LAS u32x4*)(stg + row * 64 + ch * 8);
        if (!(mode & 1)) *(u32x4*)(Ob + (long)(qrow0 + row * kstr) * opitch + ch * 8) = v; }
}

template <bool AUG> __device__ __forceinline__ int ring_kidx(int a0, int t) { if (AUG) return 64 * t; return 64 * (t < 4 ? 4 * a0 + t : t - 4); }
template <bool AUG>
__device__ __forceinline__ void unit_ring(const int b, const int h, const int a0, const Tens& T, ATT_LAS char* shm, const int wid) {
    const int lane = fresh_lane(), r32 = lane & 31, hi = lane >> 5;
    const int rb = b * SEQ, NT = 4 * a0 + 4, qmin = 256 * a0 + 32 * wid, qmax = qmin + 31, qrow0 = rb + qmin, qrow = qrow0 + r32;
    const unsigned lds0 = (unsigned)(uintptr_t)shm;
    ATT_LAS float* wsf = (ATT_LAS float*)(shm + L_WS) + wid * 64;
    const bf16* Kh = T.K + (long)rb * PITCH + h * 64; const bf16* Vh = T.V + (long)rb * PITCH + h * 64;
    const unsigned voff_k = (unsigned)(lane * PITCH + wid * 8) * 2u, voff_v = (unsigned)((16 * (wid & 3) + (lane >> 2)) * PITCH + (wid >> 2) * 32 + (lane & 3) * 8) * 2u;
#define ATT_ISSUE1(t_, sub_) do { const int kidx_ = ring_kidx<AUG>(a0, (t_)); \
        if (AUG && wid == 7) glds16s(T.KAUG + ((long)(b * 5 + h) * SEQ + kidx_), (unsigned)lane * 16u, (unsigned)__builtin_amdgcn_readfirstlane(lds0 + L_K + (sub_) * KSLOT + 8192)); \
        glds16s(Kh + (long)kidx_ * PITCH, voff_k, (unsigned)__builtin_amdgcn_readfirstlane(lds0 + L_K + (sub_) * KSLOT + wid * 1024)); \
        glds16s(Vh + (long)kidx_ * PITCH, voff_v, (unsigned)__builtin_amdgcn_readfirstlane(lds0 + L_V + (sub_) * VSLOT + wid * 1024)); } while (0)
#define ATT_ISSUE(pair_, pslot_) do { ATT_ISSUE1(2 * (pair_), 2 * (pslot_)); ATT_ISSUE1(2 * (pair_) + 1, 2 * (pslot_) + 1); } while (0)
    bf16x8 qr[4];
    { const bf16* Qw = T.Q + (long)qrow * PITCH + h * 64 + hi * 8;
#pragma unroll
      for (int d0 = 0; d0 < 4; ++d0) qr[d0] = *reinterpret_cast<const bf16x8*>(Qw + d0 * 16); }
    ATT_ISSUE(0, 0);
    unsigned sel = 0xffu;
    if (!AUG && a0 > 3) {
        float gate[7];
        const float* km = T.KMEAN + (long)((b * 5 + (h - 5)) * 8) * 64 + hi * 8;
#pragma unroll
        for (int n = 0; n < 7; ++n) { float g = 0.f;
            if (n < a0) {
#pragma unroll
                for (int d0 = 0; d0 < 4; ++d0) {
                    const float4 k0 = *(const float4*)(km + n * 64 + d0 * 16), k1 = *(const float4*)(km + n * 64 + d0 * 16 + 4);
                    const bf16x8 qv = qr[d0];
#define ATT_QF(j) __uint_as_float(((unsigned)(unsigned short)qv[j]) << 16)
                    g += ATT_QF(0) * k0.x + ATT_QF(1) * k0.y + ATT_QF(2) * k0.z + ATT_QF(3) * k0.w + ATT_QF(4) * k1.x + ATT_QF(5) * k1.y + ATT_QF(6) * k1.z + ATT_QF(7) * k1.w;
#undef ATT_QF
                }
                g += __shfl_xor(g, 32);
            }
            gate[n] = g; }
        sel = 0u;
#pragma unroll
        for (int k = 0; k < 3; ++k) { float best = -INFINITY; unsigned bi = 0u;
#pragma unroll
            for (int n = 0; n < 7; ++n) { const bool ok = (n < a0) && !((sel >> n) & 1u) && (gate[n] > best); best = ok ? gate[n] : best; bi = ok ? (unsigned)n : bi; }
            sel |= 1u << bi; }
    }
    const ATT_LAS char* shmc = (const ATT_LAS char*)shm;
    const ATT_LAS char* vpl = shmc + L_V + ((lane >> 4) & 1) * 32 + (lane & 3) * 8 + (4 * hi + ((lane & 15) >> 2)) * 64;
    St s; st_init(s); s.vprev = vpl;
    asm volatile("" : "+v"(qr[0]), "+v"(qr[1]), "+v"(qr[2]), "+v"(qr[3]));
    int slot = 0, islot = 1;
    const int ebase = qmin + r32 - 4 * hi, NP = NT / 2;
#define ATT_HEAD asm volatile("s_waitcnt vmcnt(0) lgkmcnt(0)\n\ts_barrier" ::: "memory")
#define ATT_ADV do { islot = (islot + 1 == NSLOT) ? 0 : islot + 1; slot = (slot + 1 == NSLOT) ? 0 : slot + 1; } while (0)
#define ATT_GEN_TILE(t, sub_) do { \
        const int kidx = ring_kidx<AUG>(a0, (t)); \
        const bool past = !AUG && (t) >= 4; \
        const bool need = past || (kidx <= qmax); \
        if (need) { if (past) tile_step_steady<AUG, true>(s, shmc + L_K + (sub_) * KSLOT, vpl + (sub_) * VSLOT, qr, ((sel >> (((t) - 4) >> 2)) & 1u) != 0u, wsf, r32, hi); \
                    else tile_step_steady<AUG, false>(s, shmc + L_K + (sub_) * KSLOT, vpl + (sub_) * VSLOT, qr, true, wsf, r32, hi, kidx + 63 > qmin, false, ebase - kidx); } \
        else { pv_tile(s.o, s.pw, s.vprev); _Pragma("unroll") for (int k_ = 0; k_ < 4; ++k_) s.pw[k_] = u32x4{0u, 0u, 0u, 0u}; }     \
        } while (0)
#define ATT_GEN_PAIR(i) do { ATT_HEAD; if ((i) + 1 < NP) ATT_ISSUE((i) + 1, islot); ATT_GEN_TILE(2 * (i), 2 * slot); ATT_GEN_TILE(2 * (i) + 1, 2 * slot + 1); ATT_ADV; } while (0)
#define ATT_STEADY_PAIR(i, SEL_) do { ATT_HEAD; ATT_ISSUE((i) + 1, islot); \
        tile_step_steady<AUG, SEL_>(s, shmc + L_K + (2 * slot) * KSLOT, vpl + (2 * slot) * VSLOT, qr, SEL_ ? (((sel >> ((2 * (i) - 4) >> 2)) & 1u) != 0u) : true, wsf, r32, hi); \
        tile_step_steady<AUG, SEL_>(s, shmc + L_K + (2 * slot + 1) * KSLOT, vpl + (2 * slot + 1) * VSLOT, qr, SEL_ ? (((sel >> ((2 * (i) + 1 - 4) >> 2)) & 1u) != 0u) : true, wsf, r32, hi); \
        ATT_ADV; } while (0)
    if (AUG) {
        int i = 0;
        if (NP > 2) {
#pragma unroll 1
            for (; i < NP - 2; ++i) ATT_STEADY_PAIR(i, false); }
#pragma unroll 1
        for (; i < NP; ++i) ATT_GEN_PAIR(i);
    } else {
        int i = 0;
#pragma unroll 1
        for (; i < 2; ++i) ATT_GEN_PAIR(i);
        if (NP - 1 > 2) {
#pragma unroll 1
            for (; i < NP - 1; ++i) ATT_STEADY_PAIR(i, true); }
#pragma unroll 1
        for (; i < NP; ++i) ATT_GEN_PAIR(i);
    }
#undef ATT_GEN_TILE
#undef ATT_GEN_PAIR
#undef ATT_STEADY_PAIR
#undef ATT_HEAD
#undef ATT_ADV
    pv_tile(s.o, s.pw, s.vprev); s.pend = false;
    asm volatile("s_waitcnt lgkmcnt(0)\n\ts_barrier" ::: "memory");
    unit_finish(s, wsf, (ATT_LAS bf16*)(shm + L_OST) + wid * 2048, T.O + h * 64, PITCH, qrow0, 1, nullptr, lane, r32, hi, T.mode);
    asm volatile("s_waitcnt lgkmcnt(0)\n\ts_barrier" ::: "memory");
#undef ATT_ISSUE
#undef ATT_ISSUE1
}

__device__ __forceinline__ void unit_win(const int type, const int b, const int h, const int a0, const int a1, const Tens& T, ATT_LAS char* shm, const int wid) {
    const int lane = fresh_lane(), r32 = lane & 31, hi = lane >> 5;
    const int rb = b * SEQ;
    int qmin, kstr, rofs, ntl, tw0, ntw;
    if (type == T_D1) { qmin = 256 * a0 + 32 * wid; kstr = 1; rofs = 0; ntl = 6; tw0 = wid >> 1; ntw = 3; }
    else if (type == T_D4) { qmin = 256 * a0 + 32 * wid; kstr = 4; rofs = a1; ntl = 6; tw0 = wid >> 1; ntw = 3; }
    else { qmin = 32 * (wid & 3); kstr = 16; rofs = 2 * a0 + (wid >> 2); ntl = 4; tw0 = 2 * (wid >> 2); ntw = 2; }
    const int qmax = qmin + 31, qrow0 = rb + qmin * kstr + rofs, qrow = qrow0 + r32 * kstr;
    const unsigned lds0 = (unsigned)(uintptr_t)shm;
    ATT_LAS float* wsf = (ATT_LAS float*)(shm + LD_WS) + wid * 64;
    const bf16* Kh = T.K + (long)rb * PITCH + h * 64; const bf16* Vh = T.V + (long)rb * PITCH + h * 64;
    const unsigned voff_k = (unsigned)((lane * kstr) * PITCH + wid * 8) * 2u, voff_v = (unsigned)(((16 * (wid & 3) + (lane >> 2)) * kstr) * PITCH + (wid >> 2) * 32 + (lane & 3) * 8) * 2u;
    bf16x8 qr[4];
    { const bf16* Qw = T.Q + (long)qrow * PITCH + h * 64 + hi * 8;
#pragma unroll
      for (int d0 = 0; d0 < 4; ++d0) qr[d0] = *reinterpret_cast<const bf16x8*>(Qw + d0 * 16); }
    for (int t = 0; t < ntl; ++t) {
        int kidx, row0;
        if (type == T_D16) { kidx = 64 * (t & 1); row0 = 16 * kidx + 2 * a0 + (t >> 1); } else { kidx = 256 * a0 - 128 + 64 * t; row0 = kstr * kidx + rofs; }
        if (kidx >= 0 && !(T.mode & 4)) { glds16s(Kh + (long)row0 * PITCH, voff_k, (unsigned)__builtin_amdgcn_readfirstlane(lds0 + LD_K + t * 8192 + wid * 1024));
                         glds16s(Vh + (long)row0 * PITCH, voff_v, (unsigned)__builtin_amdgcn_readfirstlane(lds0 + LD_V + t * 8192 + wid * 1024)); }
    }
    St s; st_init(s);
    const ATT_LAS char* shmc = (const ATT_LAS char*)shm;
    const ATT_LAS char* vpl = shmc + LD_V + ((lane >> 4) & 1) * 32 + (lane & 3) * 8 + (4 * hi + ((lane & 15) >> 2)) * 64;
    asm volatile("" : "+v"(qr[0]), "+v"(qr[1]), "+v"(qr[2]), "+v"(qr[3]));
    asm volatile("s_waitcnt vmcnt(0) lgkmcnt(0)\n\ts_barrier" ::: "memory");
    const int ebase = qmin + r32 - 4 * hi;
    for (int i = (T.mode & 512) ? ntw : 0; i < ntw; ++i) {
        const int t = tw0 + i;
        const int kidx = (type == T_D16) ? 64 * (t & 1) : 256 * a0 - 128 + 64 * t;
        const bool need = (kidx >= 0) && (kidx <= qmax) && !(T.mode & 2);
        if (need) tile_step<false>(s, shmc + LD_K + t * 8192, vpl + t * 8192, qr, false, true, kidx + 63 > qmin, kidx < qmax - 128, ebase - kidx, wsf, r32, hi, T.mode);
    }
    bf16* Ob; int opitch;
    if (type == T_D1) { Ob = T.O + h * 64; opitch = PITCH; } else if (type == T_D4) { Ob = T.OX1 + (h - 10) * 64; opitch = 384; } else { Ob = T.OX2 + (h - 10) * 64; opitch = 384; }
    unit_finish(s, wsf, (ATT_LAS bf16*)(shm + LD_OST) + wid * 2048, Ob, opitch, qrow0, kstr, T.LSE + ((long)(type - T_D1) * NTOK + qrow) * 6 + (h - 10), lane, r32, hi, T.mode);
    asm volatile("s_waitcnt lgkmcnt(0)\n\ts_barrier" ::: "memory");
}
struct WinP { int type, b, h, a0, a1; };
__device__ __forceinline__ WinP win_decode(int u, int x) { WinP p; const int bh = (u / 24) * 8 + x, k = u % 24; p.b = bh / 6; p.h = 10 + bh % 6; p.a1 = 0;
    if (k < 8) { p.type = T_D1; p.a0 = k; } else if (k < 16) { p.type = T_D4; p.a0 = (k - 8) >> 2; p.a1 = (k - 8) & 3; } else { p.type = T_D16; p.a0 = k - 16; } return p; }
struct WinW { int qmin, kstr, rofs, ntl, tw0, ntw; };
__device__ __forceinline__ WinW win_wave(const WinP& p, int wid) { WinW w;
    if (p.type == T_D1) { w.qmin = 256 * p.a0 + 32 * wid; w.kstr = 1; w.rofs = 0; w.ntl = 6; w.tw0 = wid >> 1; w.ntw = 3; }
    else if (p.type == T_D4) { w.qmin = 256 * p.a0 + 32 * wid; w.kstr = 4; w.rofs = p.a1; w.ntl = 6; w.tw0 = wid >> 1; w.ntw = 3; }
    else { w.qmin = 32 * (wid & 3); w.kstr = 16; w.rofs = 2 * p.a0 + (wid >> 2); w.ntl = 4; w.tw0 = 2 * (wid >> 2); w.ntw = 2; }
    return w; }
__device__ __forceinline__ void win_request(const WinP& p, const WinW& w, const Tens& T, unsigned lds0, int wid, int lane, int r32, int hi, bf16x8 (&q)[4]) {
    const int rb = p.b * SEQ, qrow = rb + (w.qmin + r32) * w.kstr + w.rofs;
    const bf16* Kh = T.K + (long)rb * PITCH + p.h * 64; const bf16* Vh = T.V + (long)rb * PITCH + p.h * 64;
    const unsigned voff_k = (unsigned)((lane * w.kstr) * PITCH + wid * 8) * 2u, voff_v = (unsigned)(((16 * (wid & 3) + (lane >> 2)) * w.kstr) * PITCH + (wid >> 2) * 32 + (lane & 3) * 8) * 2u;
    { const bf16* Qw = T.Q + (long)qrow * PITCH + p.h * 64 + hi * 8;
#pragma unroll
      for (int d0 = 0; d0 < 4; ++d0) q[d0] = *reinterpret_cast<const bf16x8*>(Qw + d0 * 16); }
    for (int t = 0; t < w.ntl; ++t) {
        int kidx, row0;
        if (p.type == T_D16) { kidx = 64 * (t & 1); row0 = 16 * kidx + 2 * p.a0 + (t >> 1); } else { kidx = 256 * p.a0 - 128 + 64 * t; row0 = w.kstr * kidx + w.rofs; }
        if (kidx >= 0) { glds16s(Kh + (long)row0 * PITCH, voff_k, (unsigned)__builtin_amdgcn_readfirstlane(lds0 + LD_K + t * 8192 + wid * 1024));
                         glds16s(Vh + (long)row0 * PITCH, voff_v, (unsigned)__builtin_amdgcn_readfirstlane(lds0 + LD_V + t * 8192 + wid * 1024)); }
    }
}
__device__ __forceinline__ void win_units(const int u0, const int ustride, const int n, const int x, const Tens& T, ATT_LAS char* shm, const int wid) {
    if (n <= 0) return;
    const int lane = fresh_lane(), r32 = lane & 31, hi = lane >> 5;
    const unsigned lds0 = (unsigned)(uintptr_t)shm;
    ATT_LAS float* wsf = (ATT_LAS float*)(shm + LD_WS) + wid * 64;
    const ATT_LAS char* shmc = (const ATT_LAS char*)shm;
    const ATT_LAS char* vpl = shmc + LD_V + ((lane >> 4) & 1) * 32 + (lane & 3) * 8 + (4 * hi + ((lane & 15) >> 2)) * 64;
    WinP p = win_decode(u0, x); WinW w = win_wave(p, wid);
    bf16x8 qr[4];
    win_request(p, w, T, lds0, wid, lane, r32, hi, qr);
#pragma unroll 1
    for (int idx = 0; idx < n; ++idx) {
        asm volatile("" : "+v"(qr[0]), "+v"(qr[1]), "+v"(qr[2]), "+v"(qr[3]));
        asm volatile("s_waitcnt vmcnt(0) lgkmcnt(0)\n\ts_barrier" ::: "memory");
        St s; st_init(s); s.vprev = vpl + (p.type == T_D16 ? 3 : 5) * 8192;
        const int qmax = w.qmin + 31, ebase = w.qmin + r32 - 4 * hi;
        for (int i = 0; i < w.ntw; ++i) {
            const int t = w.tw0 + i;
            const int kidx = (p.type == T_D16) ? 64 * (t & 1) : 256 * p.a0 - 128 + 64 * t;
            const bool need = (kidx >= 0) && (kidx <= qmax);
            if (need) tile_step_steady<false, false>(s, shmc + LD_K + t * 8192, vpl + t * 8192, qr, true, wsf, r32, hi, kidx + 63 > w.qmin, kidx < qmax - 128, ebase - kidx);
        }
        pv_tile(s.o, s.pw, s.vprev); s.pend = false;
        asm volatile("s_waitcnt lgkmcnt(0)\n\ts_barrier" ::: "memory");
        const WinP pc = p; const WinW wc = w;
        if (idx + 1 < n) { p = win_decode(u0 + (idx + 1) * ustride, x); w = win_wave(p, wid); }
        bf16x8 qn[4] = {qr[0], qr[1], qr[2], qr[3]};
        if (idx + 1 < n) win_request(p, w, T, lds0, wid, lane, r32, hi, qn);
        const int rbc = pc.b * SEQ, qrow0 = rbc + wc.qmin * wc.kstr + wc.rofs, qrow = qrow0 + r32 * wc.kstr;
        bf16* Ob; int opitch;
        if (pc.type == T_D1) { Ob = T.O + pc.h * 64; opitch = PITCH; } else if (pc.type == T_D4) { Ob = T.OX1 + (pc.h - 10) * 64; opitch = 384; } else { Ob = T.OX2 + (pc.h - 10) * 64; opitch = 384; }
        unit_finish(s, wsf, (ATT_LAS bf16*)(shm + LD_OST) + wid * 2048, Ob, opitch, qrow0, wc.kstr, T.LSE + ((long)(pc.type - T_D1) * NTOK + qrow) * 6 + (pc.h - 10), lane, r32, hi, 0);
#pragma unroll
        for (int d0 = 0; d0 < 4; ++d0) qr[d0] = qn[d0];
    }
    asm volatile("s_waitcnt lgkmcnt(0)\n\ts_barrier" ::: "memory");
}
#undef ATT_MX3
}

constexpr int NWAVES = 8;
#ifndef PG8_ALIGN
#define PG8_ALIGN true
#endif
#ifndef PG8_SP2
#define PG8_SP2 true
#endif
#ifndef DENSE_FP8
#define DENSE_FP8 1
#endif
#ifndef MK_ONE_LAUNCH
#define MK_ONE_LAUNCH 1
#endif
constexpr int BATCH = 32, SEQ = 2048, D = 1024, NTOK = BATCH * SEQ, FF = 3584, NEXP = 8, WIN_LD = 3 * D + 5;
constexpr float EPS = 1e-6f;
constexpr int NRB = NTOK / 256;
constexpr int MAXBLK = 520;
constexpr int CHUNK_BLK = 256, NCHUNK = 3;
enum { PH_PRO = 0, PH_QKV0, PH_PRE0, PH_ATT0, PH_MIX0, PH_WO0, PH_N2_0, PH_UP0, PH_DN0,
       PH_N1_1, PH_QKV1, PH_PRE1, PH_ATT1, PH_MIX1, PH_WO1, PH_N2_1, PH_SCAT, PH_MOE0, PH_FINAL = PH_MOE0 + 2 * NCHUNK, PH_COUNT };
constexpr size_t MiB = 1u << 20;
constexpr size_t WS_CTL = 0, CTL_ZERO_BYTES = 1 * MiB;
constexpr size_t WS_WIN0 = 2 * MiB, WS_WOUT0 = 8 * MiB, WS_W13_0 = 10 * MiB, WS_W2_0 = 24 * MiB;
constexpr size_t WS_WIN1 = 32 * MiB, WS_WOUT1 = 38 * MiB, WS_W13E = 40 * MiB, WS_W2E = 152 * MiB;
constexpr size_t WS_RCOS = 208 * MiB, WS_RSIN = WS_RCOS + 65536, WS_LF = 209 * MiB, WS_KMEAN = 210 * MiB + 512 * 1024, WS_KAUG = 211 * MiB;
constexpr size_t WS_TOKE = 216 * MiB, WS_TOKG = WS_TOKE + 256 * 1024, WS_TOKS = WS_TOKG + 512 * 1024, WS_HIST = WS_TOKS + 512 * 1024, WS_META = WS_HIST + 16384, WS_BLKE = WS_META + 4096;
constexpr size_t WS_ROWG = 218 * MiB, WS_LSE = 219 * MiB;
constexpr size_t WS_HB = 224 * MiB;
constexpr size_t WS_Q = 354 * MiB, WS_K = 482 * MiB, WS_V = 610 * MiB, WS_OX1 = 738 * MiB, WS_OX2 = 786 * MiB;
constexpr size_t WS_HB8 = 738 * MiB;
constexpr size_t WS_WV8_OFF = 4 * MiB;
constexpr size_t WS_H = 354 * MiB;
constexpr size_t WS_XG = 354 * MiB, WS_Y = 484 * MiB, WS_HCH = 614 * MiB, WS_XR = 840 * MiB;
constexpr size_t WS_END = 968 * MiB;
static_assert(WS_V - WS_K == WS_K - WS_Q, "Q | K | V equally spaced");
static_assert(WS_W2E + 8 * 7 * MiB <= WS_RCOS && WS_KAUG + 160 * 2048 * 16 <= WS_TOKE && WS_BLKE + 4096 <= WS_ROWG && WS_ROWG + MAXBLK * 256 * 4 <= WS_LSE && WS_LSE + 3 * (size_t)NTOK * 6 * 4 <= WS_HB, "ws map 1");
static_assert(WS_HB + (size_t)(NTOK + 1) * D * 2 <= WS_Q && WS_OX2 + (size_t)NTOK * 384 * 2 <= WS_END && WS_H + (size_t)NTOK * FF * 2 <= WS_END && WS_XG + (size_t)MAXBLK * 256 * D <= WS_Y && WS_Y + (size_t)MAXBLK * 256 * D <= WS_HCH && WS_HCH + (size_t)CHUNK_BLK * 256 * FF <= WS_XR && WS_OX2 + (size_t)NTOK * 384 * 2 <= WS_XR && WS_XR + (size_t)NTOK * D * 2 <= WS_END, "ws map 2");
constexpr int CW_BAR = 4096;
constexpr int CW_AQ0 = 8192, CW_AQ1 = 8256;
constexpr int RING_OFF = 0, RING_BYTES = 135168, LDSCTL_OFF = RING_BYTES, MISC_OFF = LDSCTL_OFF + 320, LDSX_OFF = RING_BYTES + 1024, LDS_BYTES = 147456;
static_assert(att::L_BYTES <= RING_BYTES && att::LD_BYTES <= RING_BYTES && pg8::STAGE_BYTES <= RING_BYTES && LDSX_OFF + 8192 <= LDS_BYTES, "LDS map");

#define GAS __attribute__((address_space(1)))
#define LAS __attribute__((address_space(3)))
typedef unsigned short bf16;
typedef unsigned v4u __attribute__((ext_vector_type(4)));
typedef unsigned v2u __attribute__((ext_vector_type(2)));
typedef float f32x4 __attribute__((ext_vector_type(4)));
#define RLX_AGENT __ATOMIC_RELAXED, __HIP_MEMORY_SCOPE_AGENT
#define LDS_WAIT() asm volatile("s_waitcnt lgkmcnt(0)" ::: "memory")
__device__ __forceinline__ unsigned pk2(float lo, float hi) { return pg8::cvt_pk_bf16(lo, hi); }
__device__ __forceinline__ float bf_lo(unsigned w) { return __uint_as_float(w << 16); }
__device__ __forceinline__ float bf_hi(unsigned w) { return __uint_as_float(w & 0xffff0000u); }
__device__ __forceinline__ float wave_sum(float v) {
#pragma unroll
    for (int o = 1; o < 64; o <<= 1) v += __shfl_xor(v, o);
    return v;
}

#define XB_TMO      128
#define XB_XCNT(j)  (256  + 64 * (j))
#define XB_XSUB(j)  (1280 + 64 * (j))
#define XB_XGEN(j)  (2304 + 64 * (j))
#define XB_TOP      3328
#define XB_TOPGEN   3392
#define XCD_BAR_WORDS 3456
#define XB_SPIN_CAP (1u << 18)

__device__ __forceinline__ unsigned xb_ld(unsigned* p)              { return __hip_atomic_load(p, __ATOMIC_RELAXED, __HIP_MEMORY_SCOPE_AGENT); }
__device__ __forceinline__ unsigned xb_add(unsigned* p, unsigned v) { return __hip_atomic_fetch_add(p, v, __ATOMIC_RELAXED, __HIP_MEMORY_SCOPE_AGENT); }
__device__ __forceinline__ unsigned xb_xcc_id() { return (unsigned)__builtin_amdgcn_s_getreg((3 << 11) | 20) & 0xFu; }
#define XB_SPIN(cond, bar) do { unsigned _sp = 0; while (cond) { __builtin_amdgcn_s_sleep(1); \
    if ((++_sp & 255u) == 0u) { if (xb_ld(&(bar)[XB_TMO])) break; if (_sp > XB_SPIN_CAP) { atomicAdd(&(bar)[XB_TMO], 1u); break; } } } } while (0)

struct XcdBarrier {
    unsigned* bar; unsigned x;
    volatile LAS unsigned* st;
};

__device__ __forceinline__ XcdBarrier xcd_barrier_post(unsigned* bar, volatile LAS unsigned* st, const int tid_x) {
    XcdBarrier b; b.bar = bar; b.x = xb_xcc_id(); b.st = st;
    if (tid_x == 0) (void)xb_add(&bar[XB_XCNT(b.x)], 1u);
    return b;
}
__device__ __forceinline__ void xcd_barrier_complete(unsigned* bar, unsigned x, unsigned& nloc, unsigned& nx) {
    const unsigned G = gridDim.x * gridDim.y * gridDim.z;
    unsigned sum, cnt, mine, sp = 0u;
    for (;;) {
        sum = 0u; cnt = 0u; mine = 0u;
#pragma unroll
        for (unsigned j = 0; j < 16; ++j) { const unsigned c = xb_ld(&bar[XB_XCNT(j)]); sum += c; cnt += (c > 0u) ? 1u : 0u; mine = (j == x) ? c : mine; }
        if (sum == G) break;
        __builtin_amdgcn_s_sleep(1);
        if ((++sp & 255u) == 0u) { if (xb_ld(&bar[XB_TMO])) break; if (sp > XB_SPIN_CAP) { atomicAdd(&bar[XB_TMO], 1u); break; } }
    }
    nloc = mine > 0u ? mine : 1u; nx = cnt > 0u ? cnt : 1u;
}

__device__ __forceinline__ void xcd_barrier(const XcdBarrier& b, const int tid_x) {
    asm volatile("s_waitcnt vmcnt(0)" ::: "memory");
    __syncthreads();
    if (tid_x == 0) {
        unsigned* bar = b.bar;
        __builtin_amdgcn_s_waitcnt(0);
        unsigned nloc = b.st[0], nx = b.st[1];
        if (nloc == 0u) { xcd_barrier_complete(bar, b.x, nloc, nx); b.st[0] = nloc; b.st[1] = nx; }
        const unsigned old = xb_add(&bar[XB_XSUB(b.x)], 1u);
        const unsigned gen = old / nloc;
        if (old + 1u == (gen + 1u) * nloc) {
            __builtin_amdgcn_fence(__ATOMIC_RELEASE, "agent");
            asm volatile("s_waitcnt vmcnt(0)" ::: "memory");
            const unsigned og = xb_add(&bar[XB_TOP], 1u);
            const unsigned tg = og / nx;
            if (og + 1u == (tg + 1u) * nx) xb_add(&bar[XB_TOPGEN], 1u);
            else XB_SPIN(xb_ld(&bar[XB_TOPGEN]) == tg, bar);
            __builtin_amdgcn_fence(__ATOMIC_ACQUIRE, "agent");
            xb_add(&bar[XB_XGEN(b.x)], 1u);
            asm volatile("s_waitcnt vmcnt(0)" ::: "memory");
        } else {
            XB_SPIN(xb_ld(&bar[XB_XGEN(b.x)]) == gen, bar);
            __builtin_amdgcn_fence(__ATOMIC_ACQUIRE, "agent");
            asm volatile("s_waitcnt vmcnt(0)" ::: "memory");
        }
    }
    __syncthreads();
}


__device__ __forceinline__ void tr_load(const float* W, int ld, int k0, int n0, LAS float* scr, int lane) {
    if ((ld & 3) == 0) {
        const int r = lane >> 3, c4 = lane & 7;
        f32x4 v[8];
#pragma unroll
        for (int i = 0; i < 8; ++i) v[i] = *(const f32x4*)(W + (size_t)(k0 + 8 * i + r) * ld + n0 + 4 * c4);
#pragma unroll
        for (int i = 0; i < 8; ++i) { LAS float* d = scr + (4 * c4) * 68 + 8 * i + r; d[0] = v[i].x; d[68] = v[i].y; d[136] = v[i].z; d[204] = v[i].w; }
    } else {
#pragma unroll 8
        for (int i = 0; i < 32; ++i) { const int kk = 2 * i + (lane >> 5); scr[(lane & 31) * 68 + kk] = W[(size_t)(k0 + kk) * ld + n0 + (lane & 31)]; }
    }
    LDS_WAIT(); asm volatile("" ::: "memory");
}
__device__ __forceinline__ void tr_item(const float* W, int ld, int k0, int n0, bf16* WT, int Kd, int drow0, LAS float* scr, int lane) {
    tr_load(W, ld, k0, n0, scr, lane);
    const int c = lane & 7;
#pragma unroll
    for (int j = 0; j < 4; ++j) { const int n = (lane >> 3) + 8 * j; const LAS f32x4* s = (const LAS f32x4*)(scr + n * 68 + 8 * c); const f32x4 a = s[0], b = s[1];
        v4u o; o.x = pk2(a.x, a.y); o.y = pk2(a.z, a.w); o.z = pk2(b.x, b.y); o.w = pk2(b.z, b.w);
        *(v4u*)(WT + (size_t)(drow0 + n) * Kd + k0 + 8 * c) = o; }
    LDS_WAIT(); asm volatile("" ::: "memory");
}
__device__ __forceinline__ void tr_item8(const float* W, int ld, int k0, int n0, unsigned char* WT, int Kd, int drow0, float scale, LAS float* scr, int lane) {
    tr_load(W, ld, k0, n0, scr, lane);
    const int c = lane & 3;
#pragma unroll
    for (int j = 0; j < 2; ++j) { const int n = (lane >> 2) + 16 * j; const LAS f32x4* s = (const LAS f32x4*)(scr + n * 68 + 16 * c); const f32x4 a = s[0] * scale, b = s[1] * scale, cc = s[2] * scale, d = s[3] * scale;
        v4u o; o.x = pg8::cvt_fp8x4(a.x, a.y, a.z, a.w); o.y = pg8::cvt_fp8x4(b.x, b.y, b.z, b.w); o.z = pg8::cvt_fp8x4(cc.x, cc.y, cc.z, cc.w); o.w = pg8::cvt_fp8x4(d.x, d.y, d.z, d.w);
        *(v4u*)(WT + (size_t)(drow0 + n) * Kd + k0 + 16 * c) = o; }
    LDS_WAIT(); asm volatile("" ::: "memory");
}
constexpr float WSCALE8 = 256.f; constexpr int WSCALE8_EXP = 8; constexpr float HSCALE8 = 8.f; constexpr int HSCALE8_EXP = 3; constexpr float YSCALE8 = 16.f;
struct In { const float* p[21]; };
constexpr int I_WIN = 16 * 96, I_WO = 16 * 32, I_W1 = 16 * 112, I_W2 = 56 * 32, I_FFN = 2 * I_W1 + I_W2, I_L0 = I_WIN + I_WO + I_FFN, I_L1A = I_WIN + I_WO, I_TOTAL = I_L0 + I_L1A + NEXP * I_FFN;
__device__ __forceinline__ void tr_ffn_item(int r, const float* w1, const float* w3, const float* w2, bf16* W13, bf16* W2T, LAS float* scr, int lane) {
    if (r < 2 * I_W1) { const bool up = r >= I_W1; if (up) r -= I_W1; const int kb = r / 112, nb = r % 112, n0 = 32 * nb;
        tr_item(up ? w3 : w1, FF, 64 * kb, n0, W13, D, 256 * (n0 >> 7) + (up ? 128 : 0) + (n0 & 127), scr, lane); }
    else { r -= 2 * I_W1; const int kb = r / 32, nb = r % 32; tr_item(w2, D, 64 * kb, 32 * nb, W2T, FF, 32 * nb, scr, lane); }
}
__device__ __forceinline__ void tr_ffn_item8(int r, const float* w1, const float* w3, const float* w2, unsigned char* W13, unsigned char* W2T, LAS float* scr, int lane) {
    if (r < 2 * I_W1) { const bool up = r >= I_W1; if (up) r -= I_W1; const int kb = r / 112, nb = r % 112, n0 = 32 * nb;
        tr_item8(up ? w3 : w1, FF, 64 * kb, n0, W13, D, 256 * (n0 >> 7) + (up ? 128 : 0) + (n0 & 127), WSCALE8, scr, lane); }
    else { r -= 2 * I_W1; const int kb = r / 32, nb = r % 32; tr_item8(w2, D, 64 * kb, 32 * nb, W2T, FF, 32 * nb, WSCALE8, scr, lane); }
}
__device__ __forceinline__ void tr_win_item(const float* w_in, int r, unsigned char* dst, LAS float* scr, int lane) {
    const int k0 = 64 * (r / 96), n0 = 32 * (r % 96);
    tr_item(w_in, WIN_LD, k0, n0, (bf16*)dst, D, n0, scr, lane);
}
__device__ __forceinline__ void transpose_all(const In& in, unsigned char* ws, LAS float* scr, int gw, int NGW, int lane) {
    for (int it = gw; it < I_TOTAL; it += NGW) {
        int r = it;
        if (r < I_L0) {
            if (r < I_WIN) { tr_win_item(in.p[2], r, ws + WS_WIN0, scr, lane); continue; } r -= I_WIN;
            if (r < I_WO) { tr_item(in.p[5], D, 64 * (r / 32), 32 * (r % 32), (bf16*)(ws + WS_WOUT0), D, 32 * (r % 32), scr, lane); continue; } r -= I_WO;
            if (DENSE_FP8) tr_ffn_item8(r, in.p[7], in.p[8], in.p[9], ws + WS_W13_0, ws + WS_W2_0, scr, lane);
            else tr_ffn_item(r, in.p[7], in.p[8], in.p[9], (bf16*)(ws + WS_W13_0), (bf16*)(ws + WS_W2_0), scr, lane);
            continue; }
        r -= I_L0;
        if (r < I_WIN) { tr_win_item(in.p[11], r, ws + WS_WIN1, scr, lane); continue; } r -= I_WIN;
        if (r < I_WO) { tr_item(in.p[14], D, 64 * (r / 32), 32 * (r % 32), (bf16*)(ws + WS_WOUT1), D, 32 * (r % 32), scr, lane); continue; } r -= I_WO;
        const int e = r / I_FFN; r -= e * I_FFN;
        tr_ffn_item8(r, in.p[17] + (size_t)e * D * FF, in.p[18] + (size_t)e * D * FF, in.p[19] + (size_t)e * FF * D, ws + WS_W13E + (size_t)e * 2 * FF * D, ws + WS_W2E + (size_t)e * D * FF, scr, lane);
    }
}

template <int MODE, bool OUT8, bool INB16>
__device__ __forceinline__ void norm_phase(const void* X, const float* gain, void* HBv, const float* wx, int wx_ld, int wx_c0, const float* bfp, float* LF,
                                           int* TOKE, float* TOKG, int* HIST, LAS unsigned char* lds, int tid, int lane, int wave) {
    constexpr int NX = MODE == 1 ? 5 : (MODE == 2 ? 8 : 0);
#define NP_COL(jj, cc) (INB16 ? (16 * lane + 4 * (jj) + (cc)) : (256 * (jj) + 4 * lane + (cc)))
    f32x4 g[4];
#pragma unroll
    for (int j = 0; j < 4; ++j) g[j] = *(const f32x4*)(gain + NP_COL(j, 0));
    f32x4 gw[NX > 0 ? NX : 1][4];
#pragma unroll
    for (int e = 0; e < NX; ++e)
#pragma unroll
        for (int j = 0; j < 4; ++j)
#pragma unroll
            for (int c = 0; c < 4; ++c) gw[e][j][c] = g[j][c] * wx[(size_t)NP_COL(j, c) * wx_ld + wx_c0 + e];
    float bias_l = 0.f; if (MODE == 1) { const int e = (lane >> 3) & 7; bias_l = bfp[e < 5 ? e : 0]; }
    LAS int* lh = (LAS int*)(lds + LDSX_OFF);
    for (int rbk = blockIdx.x; rbk < NRB; rbk += gridDim.x) {
        if (MODE == 2) { if (tid < 8) lh[tid] = 0; __syncthreads(); }
        for (int i = 0; i < 32; ++i) {
            const int row = rbk * 256 + wave * 32 + i;
            f32x4 v[4]; float ss = 0.f;
            if constexpr (INB16) { const v4u* xr = (const v4u*)((const bf16*)X + (size_t)row * D + 16 * lane); const v4u w0 = xr[0], w1 = xr[1];
                v[0] = (f32x4){bf_lo(w0.x), bf_hi(w0.x), bf_lo(w0.y), bf_hi(w0.y)}; v[1] = (f32x4){bf_lo(w0.z), bf_hi(w0.z), bf_lo(w0.w), bf_hi(w0.w)};
                v[2] = (f32x4){bf_lo(w1.x), bf_hi(w1.x), bf_lo(w1.y), bf_hi(w1.y)}; v[3] = (f32x4){bf_lo(w1.z), bf_hi(w1.z), bf_lo(w1.w), bf_hi(w1.w)}; }
            else { const f32x4* xr = (const f32x4*)((const float*)X + (size_t)row * D) + lane;
#pragma unroll
                for (int j = 0; j < 4; ++j) v[j] = xr[64 * j]; }
#pragma unroll
            for (int j = 0; j < 4; ++j) ss += (v[j].x * v[j].x + v[j].y * v[j].y) + (v[j].z * v[j].z + v[j].w * v[j].w);
            const float rstd = 1.0f / sqrtf(wave_sum(ss) * (1.f / D) + EPS);
            f32x4 h[4];
#pragma unroll
            for (int j = 0; j < 4; ++j) h[j] = v[j] * rstd * g[j];
            if constexpr (INB16) {
                if (OUT8) { v4u o; o.x = pg8::cvt_fp8x4(h[0].x, h[0].y, h[0].z, h[0].w); o.y = pg8::cvt_fp8x4(h[1].x, h[1].y, h[1].z, h[1].w); o.z = pg8::cvt_fp8x4(h[2].x, h[2].y, h[2].z, h[2].w); o.w = pg8::cvt_fp8x4(h[3].x, h[3].y, h[3].z, h[3].w);
                    *(v4u*)((unsigned char*)HBv + (size_t)row * D + 16 * lane) = o; }
                else { v4u o0, o1; o0.x = pk2(h[0].x, h[0].y); o0.y = pk2(h[0].z, h[0].w); o0.z = pk2(h[1].x, h[1].y); o0.w = pk2(h[1].z, h[1].w); o1.x = pk2(h[2].x, h[2].y); o1.y = pk2(h[2].z, h[2].w); o1.z = pk2(h[3].x, h[3].y); o1.w = pk2(h[3].z, h[3].w);
                    v4u* d = (v4u*)((bf16*)HBv + (size_t)row * D + 16 * lane); d[0] = o0; d[1] = o1; }
            } else {
#pragma unroll
                for (int j = 0; j < 4; ++j) {
                    if (OUT8) ((unsigned*)((unsigned char*)HBv + (size_t)row * D))[64 * j + lane] = pg8::cvt_fp8x4(h[j].x, h[j].y, h[j].z, h[j].w);
                    else ((unsigned long long*)((bf16*)HBv + (size_t)row * D))[64 * j + lane] = (unsigned long long)pk2(h[j].x, h[j].y) | ((unsigned long long)pk2(h[j].z, h[j].w) << 32); }
            }
            if (NX > 0) {
                float a8[8];
#pragma unroll
                for (int e = 0; e < 8; ++e) { float a = 0.f;
                    if (e < NX) {
#pragma unroll
                        for (int j = 0; j < 4; ++j) a += (v[j].x * gw[e][j].x + v[j].y * gw[e][j].y) + (v[j].z * gw[e][j].z + v[j].w * gw[e][j].w); }
                    a8[e] = a; }
                float a4[4], a2[2], zl;
                { const bool up = (lane & 32) != 0;
#pragma unroll
                  for (int q = 0; q < 4; ++q) { const float keep = up ? a8[q + 4] : a8[q], send = up ? a8[q] : a8[q + 4]; a4[q] = keep + __shfl_xor(send, 32); } }
                { const bool up = (lane & 16) != 0;
#pragma unroll
                  for (int q = 0; q < 2; ++q) { const float keep = up ? a4[q + 2] : a4[q], send = up ? a4[q] : a4[q + 2]; a2[q] = keep + __shfl_xor(send, 16); } }
                { const bool up = (lane & 8) != 0; const float keep = up ? a2[1] : a2[0], send = up ? a2[0] : a2[1]; zl = keep + __shfl_xor(send, 8); }
                zl += __shfl_xor(zl, 4); zl += __shfl_xor(zl, 2); zl += __shfl_xor(zl, 1);
                zl *= rstd;
                if (MODE == 1) {
                    const int b = row >> 11, s = row & 2047, e = (lane >> 3) & 7;
                    const float zz = zl + bias_l; const float ls = fminf(zz, 0.f) - log1pf(expf(-fabsf(zz)));
                    if ((lane & 7) == 0 && e < 5) LF[(size_t)(b * 5 + e) * SEQ + s] = ls;
                } else if (MODE == 2) {
                    float z[8];
#pragma unroll
                    for (int e = 0; e < 8; ++e) z[e] = __uint_as_float(__builtin_amdgcn_readlane(__float_as_uint(zl), 8 * e));
                    int e1 = 0; float v1 = z[0];
#pragma unroll
                    for (int e = 1; e < NX; ++e) if (z[e] > v1) { v1 = z[e]; e1 = e; }
                    int e2 = -1; float v2 = -INFINITY;
#pragma unroll
                    for (int e = 0; e < NX; ++e) if (e != e1 && z[e] > v2) { v2 = z[e]; e2 = e; }
                    const float g1 = 1.f / (1.f + expf(v2 - v1)), g2 = 1.f - g1;
                    if (lane == 0) { TOKE[row] = e1 | (e2 << 8); TOKG[2 * row] = g1; TOKG[2 * row + 1] = g2; __hip_atomic_fetch_add(&lh[e1], 1, __ATOMIC_RELAXED, __HIP_MEMORY_SCOPE_WORKGROUP); __hip_atomic_fetch_add(&lh[e2], 1, __ATOMIC_RELAXED, __HIP_MEMORY_SCOPE_WORKGROUP); }
                }
            }
        }
        if (MODE == 2) { __syncthreads(); if (tid < 8) HIST[rbk * 8 + tid] = lh[tid]; __syncthreads(); }
    }
#undef NP_COL
}

__device__ __forceinline__ unsigned f2bf_bits(float f) { return pk2(f, 0.f) & 0xffffu; }
__device__ __forceinline__ void preattn_phase(const float* LF, v4u* KAUG, const bf16* Kb, float* KMEAN, int gw, int NGW, int lane) {
    for (int it = gw; it < 160 + 1280; it += NGW) {
        if (it < 160) {
            const float* src = LF + (size_t)it * SEQ + 32 * lane; float v[32];
#pragma unroll
            for (int q = 0; q < 8; ++q) { const f32x4 x = *(const f32x4*)(src + 4 * q); v[4 * q] = x.x; v[4 * q + 1] = x.y; v[4 * q + 2] = x.z; v[4 * q + 3] = x.w; }
#pragma unroll
            for (int q = 1; q < 32; ++q) v[q] += v[q - 1];
            float incl = v[31];
#pragma unroll
            for (int o = 1; o < 64; o <<= 1) { const float t = __shfl_up(incl, o); if (lane >= o) incl += t; }
            const float excl = incl - v[31];
            v4u* dst = KAUG + (size_t)it * SEQ + 32 * lane;
#pragma unroll
            for (int q = 0; q < 32; ++q) { const float x = -(excl + v[q]) * 1.4426950408889634f;
                const unsigned h1 = f2bf_bits(x); const float r1 = x - __uint_as_float(h1 << 16);
                const unsigned h2 = f2bf_bits(r1); const float r2 = r1 - __uint_as_float(h2 << 16);
                const unsigned h3 = f2bf_bits(r2);
                v4u o; o.x = h1 | (h2 << 16); o.y = h3; o.z = 0u; o.w = 0u; dst[q] = o; }
        } else {
            const int r = it - 160, n = r & 7, bh = r >> 3, b = bh / 5, h = 5 + bh % 5;
            const bf16* src = Kb + (size_t)(b * SEQ + 256 * n + (lane >> 3)) * D + h * 64 + (lane & 7) * 8;
            float a[8] = {0.f, 0.f, 0.f, 0.f, 0.f, 0.f, 0.f, 0.f};
#pragma unroll 8
            for (int q = 0; q < 32; ++q) { const v4u w = *(const v4u*)(src + (size_t)q * 8 * D);
                a[0] += bf_lo(w.x); a[1] += bf_hi(w.x); a[2] += bf_lo(w.y); a[3] += bf_hi(w.y); a[4] += bf_lo(w.z); a[5] += bf_hi(w.z); a[6] += bf_lo(w.w); a[7] += bf_hi(w.w); }
#pragma unroll
            for (int j = 0; j < 8; ++j) { a[j] += __shfl_xor(a[j], 8); a[j] += __shfl_xor(a[j], 16); a[j] += __shfl_xor(a[j], 32); }
            if (lane < 8) { float* dst = KMEAN + (size_t)r * 64 + lane * 8;
                *(f32x4*)dst = (f32x4){a[0], a[1], a[2], a[3]} * (1.f / 256.f); *(f32x4*)(dst + 4) = (f32x4){a[4], a[5], a[6], a[7]} * (1.f / 256.f); }
        }
    }
}

constexpr int NU_AB = 2 * 160 * 8, NU_C = 192 * 24, NU_ATT = NU_AB + NU_C, NPAIR = 2 * 160 * 4;
__device__ __forceinline__ void attn_phase(const att::Tens& T, LAS unsigned char* lds, int wave, const int do_ab = 1, const int do_c = 1) {
    const int G = gridDim.x, x = blockIdx.x & 7, l = blockIdx.x >> 3, LX = G >> 3;
    if ((G & 7) == 0 && LX >= 4) {
        const int ngrp = LX >> 2, g = l >> 2, m = l & 3;
        if (do_ab && g < ngrp) for (int s = g * 8 + x; s < 320; s += ngrp * 8) { const int ty = s / 160, bh = s % 160, b = bh / 5, h5 = bh % 5;
#pragma unroll 1
            for (int half = 0; half < 2; ++half) { const int qb = half ? m : 7 - m;
                if (ty == 0) att::unit_ring<true>(b, h5, qb, T, (LAS char*)(lds + RING_OFF), wave);
                else att::unit_ring<false>(b, 5 + h5, qb, T, (LAS char*)(lds + RING_OFF), wave); } }
        if (do_c) att::win_units(l, LX, (24 * 24 - l + LX - 1) / LX, x, T, (LAS char*)(lds + RING_OFF), wave);
    } else {
        const int c = blockIdx.x;
        if (do_ab) for (int p = c; p < NPAIR; p += G) { const int pt = p / 320, rem = p % 320, ty = rem / 160, bh = rem % 160, b = bh / 5, h5 = bh % 5;
#pragma unroll 1
            for (int half = 0; half < 2; ++half) { const int qb = half ? pt : 7 - pt;
                if (ty == 0) att::unit_ring<true>(b, h5, qb, T, (LAS char*)(lds + RING_OFF), wave);
                else att::unit_ring<false>(b, 5 + h5, qb, T, (LAS char*)(lds + RING_OFF), wave); } }
        if (do_c) for (int j = c; j < NU_C; j += G) { const int bh = j / 24, k = j % 24, b = bh / 6, h = 10 + bh % 6;
            int type, a0, a1 = 0;
            if (k < 8) { type = att::T_D1; a0 = k; } else if (k < 16) { type = att::T_D4; a0 = (k - 8) >> 2; a1 = (k - 8) & 3; } else { type = att::T_D16; a0 = k - 16; }
            att::unit_win(type, b, h, a0, a1, T, (LAS char*)(lds + RING_OFF), wave); }
    }
}

__device__ __forceinline__ void mixnorm_phase(const bf16* O, const bf16* OX1, const bf16* OX2, const float* LSE, const float* mgain, bf16* Y, int gw, int NGW, int lane) {
    f32x4 g[4];
#pragma unroll
    for (int j = 0; j < 4; ++j) g[j] = *(const f32x4*)(mgain + 16 * lane + 4 * j);
    const int grp = lane < 20 ? 0 : (lane < 40 ? 1 : 2);
    const int lc = grp == 2 ? lane - 40 : 0, hh = lc >> 2;
    struct Raw { v4u w0, w1, a0, a1, b0, b1; float L0, L1, L2; };
    auto load_row = [&](int row, Raw& r) {
        const v4u* src = (const v4u*)(O + (size_t)row * D + 16 * lane); r.w0 = src[0]; r.w1 = src[1];
        const v4u* s1 = (const v4u*)(OX1 + (size_t)row * 384 + 16 * lc); const v4u* s2 = (const v4u*)(OX2 + (size_t)row * 384 + 16 * lc);
        r.a0 = s1[0]; r.a1 = s1[1]; r.b0 = s2[0]; r.b1 = s2[1];
        r.L0 = LSE[(size_t)row * 6 + hh]; r.L1 = LSE[((size_t)NTOK + row) * 6 + hh]; r.L2 = LSE[((size_t)2 * NTOK + row) * 6 + hh]; };
    Raw nx; if (gw < NTOK) load_row(gw, nx);
    for (int row = gw; row < NTOK; row += NGW) {
        const Raw r = nx;
        if (row + NGW < NTOK) load_row(row + NGW, nx);
        float f[16];
        { const v4u w0 = r.w0, w1 = r.w1;
          f[0] = bf_lo(w0.x); f[1] = bf_hi(w0.x); f[2] = bf_lo(w0.y); f[3] = bf_hi(w0.y); f[4] = bf_lo(w0.z); f[5] = bf_hi(w0.z); f[6] = bf_lo(w0.w); f[7] = bf_hi(w0.w);
          f[8] = bf_lo(w1.x); f[9] = bf_hi(w1.x); f[10] = bf_lo(w1.y); f[11] = bf_hi(w1.y); f[12] = bf_lo(w1.z); f[13] = bf_hi(w1.z); f[14] = bf_lo(w1.w); f[15] = bf_hi(w1.w); }
        if (grp == 2) {
            const float mx = fmaxf(r.L0, fmaxf(r.L1, r.L2));
            float w0 = __builtin_amdgcn_exp2f(r.L0 - mx), w1 = __builtin_amdgcn_exp2f(r.L1 - mx), w2 = __builtin_amdgcn_exp2f(r.L2 - mx);
            const float inv = 1.f / (w0 + w1 + w2); w0 *= inv; w1 *= inv; w2 *= inv;
            const v4u a0 = r.a0, a1 = r.a1, b0 = r.b0, b1 = r.b1;
#define MIXC(i, wa, wb, hi_) f[i] = w0 * f[i] + w1 * (hi_ ? bf_hi(wa) : bf_lo(wa)) + w2 * (hi_ ? bf_hi(wb) : bf_lo(wb))
            MIXC(0, a0.x, b0.x, 0); MIXC(1, a0.x, b0.x, 1); MIXC(2, a0.y, b0.y, 0); MIXC(3, a0.y, b0.y, 1); MIXC(4, a0.z, b0.z, 0); MIXC(5, a0.z, b0.z, 1); MIXC(6, a0.w, b0.w, 0); MIXC(7, a0.w, b0.w, 1);
            MIXC(8, a1.x, b1.x, 0); MIXC(9, a1.x, b1.x, 1); MIXC(10, a1.y, b1.y, 0); MIXC(11, a1.y, b1.y, 1); MIXC(12, a1.z, b1.z, 0); MIXC(13, a1.z, b1.z, 1); MIXC(14, a1.w, b1.w, 0); MIXC(15, a1.w, b1.w, 1);
#undef MIXC
        }
        float ss = 0.f;
#pragma unroll
        for (int i = 0; i < 16; ++i) ss += f[i] * f[i];
        const float sT = wave_sum(ss), sA = wave_sum(grp == 0 ? ss : 0.f), sC = wave_sum(grp == 2 ? ss : 0.f), sB = sT - sA - sC;
        const float rs = grp == 0 ? 1.0f / sqrtf(sA * (1.f / 320.f) + EPS) : (grp == 1 ? 1.0f / sqrtf(fmaxf(sB, 0.f) * (1.f / 320.f) + EPS) : 1.0f / sqrtf(sC * (1.f / 384.f) + EPS));
        v4u o0, o1;
        o0.x = pk2(f[0] * rs * g[0].x, f[1] * rs * g[0].y); o0.y = pk2(f[2] * rs * g[0].z, f[3] * rs * g[0].w); o0.z = pk2(f[4] * rs * g[1].x, f[5] * rs * g[1].y); o0.w = pk2(f[6] * rs * g[1].z, f[7] * rs * g[1].w);
        o1.x = pk2(f[8] * rs * g[2].x, f[9] * rs * g[2].y); o1.y = pk2(f[10] * rs * g[2].z, f[11] * rs * g[2].w); o1.z = pk2(f[12] * rs * g[3].x, f[13] * rs * g[3].y); o1.w = pk2(f[14] * rs * g[3].z, f[15] * rs * g[3].w);
        v4u* dst = (v4u*)(Y + (size_t)row * D + 16 * lane); dst[0] = o0; dst[1] = o1;
    }
}

__device__ __forceinline__ void scatter_phase(const int* TOKE, const float* TOKG, const int* HIST, int* TOKS, float* ROWG, int* META, int* BLKE, const bf16* HB, bf16* XG,
                                              LAS unsigned char* lds, int tid, int lane, int wave) {
    LAS int* L = (LAS int*)(lds + LDSX_OFF);
    for (int rbk = blockIdx.x; rbk < NRB; rbk += gridDim.x) {
        if (tid < 32) L[tid] = 0;
        __syncthreads();
        { const int e = tid & 7, part = tid >> 3; int p = 0, tt = 0;
#pragma unroll
          for (int q = 0; q < 4; ++q) { const int r2 = part * 4 + q; const int v = HIST[r2 * 8 + e]; tt += v; if (r2 < rbk) p += v; }
          __hip_atomic_fetch_add(&L[e], p, __ATOMIC_RELAXED, __HIP_MEMORY_SCOPE_WORKGROUP); __hip_atomic_fetch_add(&L[8 + e], tt, __ATOMIC_RELAXED, __HIP_MEMORY_SCOPE_WORKGROUP); }
        __syncthreads();
        if (tid == 0) { int ps = 0;
            for (int e = 0; e < 8; ++e) { L[16 + e] = ps; ps += (L[8 + e] + 255) & ~255; }
            L[24] = ps >> 8; }
        __syncthreads();
        if (wave == 0) {
            int run[8] = {0, 0, 0, 0, 0, 0, 0, 0};
            for (int j = 0; j < 8; ++j) { const int a = 64 * j + lane, t = rbk * 256 + (a >> 1), k = a & 1; const int e = (TOKE[t] >> (8 * k)) & 0xff; int rank = 0;
#pragma unroll
                for (int e2 = 0; e2 < 8; ++e2) { const unsigned long long m = __ballot(e == e2); if (e == e2) rank = run[e2] + __popcll(m & ((1ull << lane) - 1ull)); run[e2] += __popcll(m); }
                const int dest = L[16 + e] + L[e] + rank;
                ROWG[dest] = TOKG[2 * t + k]; TOKS[2 * t + k] = dest; L[32 + a] = dest; }
        }
        __syncthreads();
        for (int i = 0; i < 64; ++i) { const int a = wave * 64 + i, t = rbk * 256 + (a >> 1), dest = L[32 + a];
            const v4u* src = (const v4u*)((const unsigned char*)HB + (size_t)t * D) + lane; v4u* dst = (v4u*)((unsigned char*)XG + (size_t)dest * D) + lane;
            const v4u x0 = src[0]; dst[0] = x0; }
        if (rbk == 0) {
            for (int e = 0; e < 8; ++e) { const int st = L[16 + e], tot = L[8 + e], pad = ((tot + 255) & ~255) - tot;
                for (int i = wave; i < pad; i += NWAVES) { v4u* dst = (v4u*)((unsigned char*)XG + (size_t)(st + tot + i) * D) + lane; const v4u zz = {0u, 0u, 0u, 0u}; dst[0] = zz; if (lane == 0) ROWG[st + tot + i] = 0.f; }
                const int nb = (tot + 255) >> 8; for (int i = tid; i < nb; i += NWAVES * 64) BLKE[(st >> 8) + i] = e; }
            if (tid == 0) META[0] = L[24];
        }
        __syncthreads();
    }
}

__device__ __forceinline__ void final_phase(const bf16* XR, float* out, const unsigned char* Y8, const int* TOKS, const float* gain, int gw, int NGW, int lane) {
    f32x4 g[4];
#pragma unroll
    for (int j = 0; j < 4; ++j) g[j] = *(const f32x4*)(gain + 16 * lane + 4 * j);
    for (int row = gw; row < NTOK; row += NGW) {
        const int s0 = TOKS[2 * row], s1 = TOKS[2 * row + 1];
        const v4u* xr = (const v4u*)(XR + (size_t)row * D + 16 * lane); const v4u w0 = xr[0], w1 = xr[1];
        const v4u ya = *(const v4u*)(Y8 + (size_t)s0 * D + 16 * lane), yb = *(const v4u*)(Y8 + (size_t)s1 * D + 16 * lane);
        f32x4 v[4];
        v[0] = (f32x4){bf_lo(w0.x), bf_hi(w0.x), bf_lo(w0.y), bf_hi(w0.y)}; v[1] = (f32x4){bf_lo(w0.z), bf_hi(w0.z), bf_lo(w0.w), bf_hi(w0.w)};
        v[2] = (f32x4){bf_lo(w1.x), bf_hi(w1.x), bf_lo(w1.y), bf_hi(w1.y)}; v[3] = (f32x4){bf_lo(w1.z), bf_hi(w1.z), bf_lo(w1.w), bf_hi(w1.w)};
        float ss = 0.f;
#pragma unroll
        for (int j = 0; j < 4; ++j) { const unsigned a = ya[j], b = yb[j];
            v[j].x += (__builtin_amdgcn_cvt_f32_fp8(a, 0) + __builtin_amdgcn_cvt_f32_fp8(b, 0)) * (1.f / YSCALE8); v[j].y += (__builtin_amdgcn_cvt_f32_fp8(a, 1) + __builtin_amdgcn_cvt_f32_fp8(b, 1)) * (1.f / YSCALE8);
            v[j].z += (__builtin_amdgcn_cvt_f32_fp8(a, 2) + __builtin_amdgcn_cvt_f32_fp8(b, 2)) * (1.f / YSCALE8); v[j].w += (__builtin_amdgcn_cvt_f32_fp8(a, 3) + __builtin_amdgcn_cvt_f32_fp8(b, 3)) * (1.f / YSCALE8);
            ss += (v[j].x * v[j].x + v[j].y * v[j].y) + (v[j].z * v[j].z + v[j].w * v[j].w); }
        const float rstd = 1.0f / sqrtf(wave_sum(ss) * (1.f / D) + EPS);
        f32x4* o = (f32x4*)(out + (size_t)row * D + 16 * lane);
#pragma unroll
        for (int j = 0; j < 4; ++j) o[j] = v[j] * rstd * g[j];
    }
}

struct Args { In in; float* out; unsigned char* ws; int ph_lo, ph_hi; int probe_rt, pad; };
__global__ void __launch_bounds__(NWAVES * 64, 2) mk_fwd(Args args) {
    extern __shared__ __attribute__((aligned(16))) unsigned char lds_raw[];
    LAS unsigned char* lds = (LAS unsigned char*)lds_raw;
    volatile LAS unsigned* MISC = (volatile LAS unsigned*)(lds + MISC_OFF);
    const int tid0 = threadIdx.x, wave = __builtin_amdgcn_readfirstlane(tid0 >> 6);
    const int G = gridDim.x, gw = blockIdx.x * NWAVES + wave, NGW = G * NWAVES;
    unsigned char* ws = args.ws; const In& in = args.in; float* out = args.out;
    unsigned* ctl = (unsigned*)(ws + WS_CTL);
    for (int u = tid0; u < (LDS_BYTES - LDSCTL_OFF) / 4; u += NWAVES * 64) ((LAS unsigned*)(lds + LDSCTL_OFF))[u] = 0u;
    __syncthreads();
#if MK_ONE_LAUNCH
    XcdBarrier bar = xcd_barrier_post(ctl + CW_BAR, MISC + 8, tid0);
#define GRID_BAR() xcd_barrier(bar, wave * 64 + fresh_lane())
#else
#define GRID_BAR() do {} while (0)
#endif
    const int lo = args.ph_lo, hi = args.ph_hi;
#ifndef PHASE_ON
#define PHASE_ON(k) 1
#endif
#define IN(k) (PHASE_ON(k) && lo <= (k) && (k) < hi)
#ifndef PROBE_PHASE
#define PROBE_PHASE -1
#endif
#ifndef PROBE_RT
#define PROBE_RT 0
#endif
#ifndef PROBE_ATT_MODE
#define PROBE_ATT_MODE 0
#endif
#ifndef PROBE_ATT_AB
#define PROBE_ATT_AB 1
#define PROBE_ATT_C 1
#endif
#define SEAM(k) do { if (IN((k) + 1)) GRID_BAR(); } while (0)
    bf16* HB = (bf16*)(ws + WS_HB); bf16* Qb = (bf16*)(ws + WS_Q); bf16* Kb = (bf16*)(ws + WS_K); bf16* Vb = (bf16*)(ws + WS_V);
    bf16* OX1 = (bf16*)(ws + WS_OX1); bf16* OX2 = (bf16*)(ws + WS_OX2); float* LSE = (float*)(ws + WS_LSE);
    float* LF = (float*)(ws + WS_LF); v4u* KAUG = (v4u*)(ws + WS_KAUG); float* KMEAN = (float*)(ws + WS_KMEAN);
    float* RCOS = (float*)(ws + WS_RCOS); float* RSIN = (float*)(ws + WS_RSIN);
    int* TOKE = (int*)(ws + WS_TOKE); float* TOKG = (float*)(ws + WS_TOKG); int* TOKS = (int*)(ws + WS_TOKS); int* HIST = (int*)(ws + WS_HIST); int* META = (int*)(ws + WS_META); int* BLKE = (int*)(ws + WS_BLKE);
    float* ROWG = (float*)(ws + WS_ROWG); bf16* Hd = (bf16*)(ws + WS_H); bf16* XR = (bf16*)(ws + WS_XR); bf16* XG = (bf16*)(ws + WS_XG); bf16* Yb = (bf16*)(ws + WS_Y); bf16* HCH = (bf16*)(ws + WS_HCH);

#define PHASE(k, ...) if (IN(k)) { { constexpr int rep_ = 0; (void)rep_; const int lane = fresh_lane(), tid = wave * 64 + lane; (void)tid; __VA_ARGS__ } SEAM(k); if ((k) == PROBE_PHASE) { { constexpr int rep_ = 1; (void)rep_; const int lane = fresh_lane(), tid = wave * 64 + lane; (void)tid; __VA_ARGS__ } SEAM(k); } }
    PHASE(PH_PRO,
        transpose_all(in, ws, (LAS float*)(lds + RING_OFF + wave * 16384), gw, NGW, lane);
        for (int i = blockIdx.x * NWAVES * 64 + tid; i < SEQ * 8; i += G * NWAVES * 64) { const int pos = i >> 3; const int k = i & 7;
            const float inv = exp2f(-(float)k * (18.931568569324174f / 8.f)); const float ang = (float)pos * inv; float rev = ang * 0.15915494309189535f; rev -= floorf(rev);
            RCOS[i] = __builtin_amdgcn_cosf(rev); RSIN[i] = __builtin_amdgcn_sinf(rev); }
        if (blockIdx.x == 0) for (int i = tid; i < D / 2; i += NWAVES * 64) ((unsigned*)(HB + (size_t)NTOK * D))[i] = 0u;
        norm_phase<1, false, false>(in.p[0], in.p[1], HB, in.p[2], WIN_LD, 3 * D, in.p[3], LF, nullptr, nullptr, nullptr, lds, tid, lane, wave);)
#define LAYER_MIX(XIN, XIN32, PQKV, PPRE, PATT, PMIX, PWO, WIN_OFF, WOUT_OFF, MGAIN, AQ) \
    PHASE(PQKV, pg8::Gemm g{HB, (const bf16*)(ws + WIN_OFF), NTOK, 3 * D, D}; pg8::StaticOrder S; S.init(NTOK, 3 * D, G, (int)blockIdx.x); \
        pg8::EpiQKV E{Qb, (size_t)(WS_K - WS_Q) / 2, RCOS, RSIN, att::C2, 5, 0, rep_ ? args.probe_rt : 0}; \
        pg8::gemm_phase<pg8::EpiQKV, pg8::StaticOrder, PG8_ALIGN, PG8_SP2>(lds + RING_OFF, g, S, E, wave);) \
    PHASE(PPRE, preattn_phase(LF, KAUG, Kb, KMEAN, gw, NGW, lane);) \
    PHASE(PATT, const att::Tens T{Qb, Kb, Vb, HB, OX1, OX2, LSE, (const att::u32x4*)KAUG, KMEAN, rep_ ? args.probe_rt : 0}; attn_phase(T, lds, wave, rep_ ? PROBE_ATT_AB : 1, rep_ ? PROBE_ATT_C : 1);) \
    PHASE(PMIX, mixnorm_phase(HB, OX1, OX2, LSE, MGAIN, Qb, gw, NGW, lane);) \
    PHASE(PWO, pg8::Gemm g{Qb, (const bf16*)(ws + WOUT_OFF), NTOK, D, D}; pg8::StaticOrder S; S.init(NTOK, D, G, (int)blockIdx.x); \
        pg8::EpiRes<XIN32> E{XIN, XR, D}; \
        pg8::gemm_phase<pg8::EpiRes<XIN32>, pg8::StaticOrder, PG8_ALIGN, PG8_SP2>(lds + RING_OFF, g, S, E, wave);)

    LAYER_MIX(in.p[0], true, PH_QKV0, PH_PRE0, PH_ATT0, PH_MIX0, PH_WO0, WS_WIN0, WS_WOUT0, in.p[4], CW_AQ0)
#if DENSE_FP8
    PHASE(PH_N2_0, norm_phase<0, true, true>(XR, in.p[6], HB, nullptr, 0, 0, nullptr, nullptr, nullptr, nullptr, nullptr, lds, tid, lane, wave);)
    PHASE(PH_UP0, pg8::Gemm g{HB, (const bf16*)(ws + WS_W13_0), NTOK, 2 * FF, D / 2}; pg8::StaticOrder S; S.init(NTOK, 2 * FF, G, (int)blockIdx.x);
        pg8::EpiSwiglu<true> E{Hd, FF, HSCALE8, rep_ ? args.probe_rt : 0};
        pg8::gemm_phase<pg8::EpiSwiglu<true>, pg8::StaticOrder, PG8_ALIGN, PG8_SP2, true>(lds + RING_OFF, g, S, E, wave, 127 - WSCALE8_EXP);)
    PHASE(PH_DN0, pg8::Gemm g{Hd, (const bf16*)(ws + WS_W2_0), NTOK, D, FF / 2}; pg8::StaticOrder S; S.init(NTOK, D, G, (int)blockIdx.x);
        pg8::EpiRes<false> E{XR, XR, D};
        pg8::gemm_phase<pg8::EpiRes<false>, pg8::StaticOrder, PG8_ALIGN, PG8_SP2, true>(lds + RING_OFF, g, S, E, wave, 127 - WSCALE8_EXP - HSCALE8_EXP);)
#else
    PHASE(PH_N2_0, norm_phase<0, false, true>(XR, in.p[6], HB, nullptr, 0, 0, nullptr, nullptr, nullptr, nullptr, nullptr, lds, tid, lane, wave);)
    PHASE(PH_UP0, pg8::Gemm g{HB, (const bf16*)(ws + WS_W13_0), NTOK, 2 * FF, D}; pg8::StaticOrder S; S.init(NTOK, 2 * FF, G, (int)blockIdx.x);
        pg8::EpiSwiglu<false> E{Hd, FF, 1.f, 0};
        pg8::gemm_phase<pg8::EpiSwiglu<false>, pg8::StaticOrder, PG8_ALIGN, PG8_SP2>(lds + RING_OFF, g, S, E, wave);)
    PHASE(PH_DN0, pg8::Gemm g{Hd, (const bf16*)(ws + WS_W2_0), NTOK, D, FF}; pg8::StaticOrder S; S.init(NTOK, D, G, (int)blockIdx.x);
        pg8::EpiRes<false> E{XR, XR, D};
        pg8::gemm_phase<pg8::EpiRes<false>, pg8::StaticOrder, PG8_ALIGN, PG8_SP2>(lds + RING_OFF, g, S, E, wave);)
#endif
    PHASE(PH_N1_1, norm_phase<1, false, true>(XR, in.p[10], HB, in.p[11], WIN_LD, 3 * D, in.p[12], LF, nullptr, nullptr, nullptr, lds, tid, lane, wave);)
    LAYER_MIX(XR, false, PH_QKV1, PH_PRE1, PH_ATT1, PH_MIX1, PH_WO1, WS_WIN1, WS_WOUT1, in.p[13], CW_AQ1)
    PHASE(PH_N2_1, norm_phase<2, true, true>(XR, in.p[15], HB, in.p[16], NEXP, 0, nullptr, nullptr, TOKE, TOKG, HIST, lds, tid, lane, wave);)
    PHASE(PH_SCAT, scatter_phase(TOKE, TOKG, HIST, TOKS, ROWG, META, BLKE, HB, XG, lds, tid, lane, wave);)
#pragma unroll 1
    for (int c = 0; c < NCHUNK; ++c) {
        const int pu = PH_MOE0 + 2 * c, pd = pu + 1;
        if (IN(pu) || IN(pd)) {
            const int nblk = __builtin_amdgcn_readfirstlane(META[0]); int nb = nblk - c * CHUNK_BLK; nb = nb < 0 ? 0 : (nb > CHUNK_BLK ? CHUNK_BLK : nb);
            LAS int* be = (LAS int*)(lds + LDSX_OFF);
            __syncthreads();
            for (int i = wave * 64 + fresh_lane(); i < nb; i += NWAVES * 64) be[i] = BLKE[c * CHUNK_BLK + i];
            __syncthreads();
#define MOE_UP { pg8::Gemm g{XG + (size_t)c * CHUNK_BLK * 256 * (D / 2), (const bf16*)(ws + WS_W13E), nb * 256, 2 * FF, D / 2}; \
                pg8::MoeOrder S; S.init(nb * 256, 2 * FF, G, (int)blockIdx.x); S.be_lds = be; S.estride = (size_t)2 * FF * D; \
                pg8::EpiSwiglu<true> E{HCH, FF, HSCALE8, 0}; \
                pg8::gemm_phase<pg8::EpiSwiglu<true>, pg8::MoeOrder, PG8_ALIGN, PG8_SP2, true>(lds + RING_OFF, g, S, E, wave, 127 - WSCALE8_EXP); SEAM(pu); }
#define MOE_DN { pg8::Gemm g{HCH, (const bf16*)(ws + WS_W2E), nb * 256, D, FF / 2}; \
                pg8::MoeOrder S; S.init(nb * 256, D, G, (int)blockIdx.x); S.be_lds = be; S.estride = (size_t)D * FF; \
                pg8::EpiY E{(unsigned char*)Yb, ROWG, c * CHUNK_BLK * 256, YSCALE8}; \
                pg8::gemm_phase<pg8::EpiY, pg8::MoeOrder, PG8_ALIGN, PG8_SP2, true>(lds + RING_OFF, g, S, E, wave, 127 - WSCALE8_EXP - HSCALE8_EXP); SEAM(pd); }
            if (IN(pu)) { MOE_UP if (PROBE_PHASE == PH_MOE0) MOE_UP }
            if (IN(pd)) { MOE_DN if (PROBE_PHASE == PH_MOE0 + 1) MOE_DN }
        }
    }
    if (IN(PH_FINAL)) final_phase(XR, out, (const unsigned char*)Yb, TOKS, in.p[20], gw, NGW, fresh_lane());
#undef IN
#undef SEAM
}

extern "C" void kernel_launch(void* const* d_in, const int* in_sizes, int n_in, void* d_out, int out_size, void* d_ws, size_t ws_size, hipStream_t stream) {
    static int grid = 0;
    if (grid == 0) {
        if (n_in != 21 || in_sizes[0] != NTOK * D || out_size != NTOK * D || ws_size < WS_END) { fprintf(stderr, "kernel_launch: unexpected shapes (n_in %d, in0 %d, out %d, ws %zu); nothing launched\n", n_in, n_in > 0 ? in_sizes[0] : -1, out_size, ws_size); grid = -1; return; }
        int dev = 0, cus = 0, per_cu = 0;
        if (hipGetDevice(&dev) != hipSuccess || hipDeviceGetAttribute(&cus, hipDeviceAttributeMultiprocessorCount, dev) != hipSuccess) { grid = -1; return; }
        if (hipFuncSetAttribute((const void*)mk_fwd, hipFuncAttributeMaxDynamicSharedMemorySize, LDS_BYTES) != hipSuccess) { fprintf(stderr, "kernel_launch: hipFuncSetAttribute failed\n"); grid = -1; return; }
        if (hipOccupancyMaxActiveBlocksPerMultiprocessor(&per_cu, (const void*)mk_fwd, NWAVES * 64, LDS_BYTES) != hipSuccess || per_cu < 1) { fprintf(stderr, "kernel_launch: occupancy query reports %d blocks per CU\n", per_cu); }
        (void)hipGetLastError();
        grid = cus;
    }
    if (grid < 0) return;
    if (hipMemsetAsync((char*)d_ws + WS_CTL, 0, CTL_ZERO_BYTES, stream) != hipSuccess) return;
    Args a{};
    for (int i = 0; i < 21; ++i) a.in.p[i] = (const float*)d_in[i];
    a.out = (float*)d_out; a.ws = (unsigned char*)d_ws; a.probe_rt = PROBE_RT;
#if MK_ONE_LAUNCH
    a.ph_lo = 0; a.ph_hi = PH_COUNT;
    hipLaunchKernelGGL(mk_fwd, dim3(grid), dim3(NWAVES * 64), LDS_BYTES, stream, a);
#else
    for (int p = 0; p < PH_COUNT; ++p) { a.ph_lo = p; a.ph_hi = p + 1; hipLaunchKernelGGL(mk_fwd, dim3(grid), dim3(NWAVES * 64), LDS_BYTES, stream, a); }
#endif
}
```

```cpp
#include <hip/hip_runtime.h>
#include <hip/hip_bf16.h>
#include <cstdio>
#include <cstdint>
#include <cmath>
__device__ __forceinline__ int fresh_lane() { int l; asm volatile("v_mbcnt_lo_u32_b32 %0, -1, 0\n\tv_mbcnt_hi_u32_b32 %0, -1, %0" : "=v"(l)); return l; }
namespace pg8 {
#define PG8_LAS __attribute__((address_space(3)))
typedef unsigned short bf16_t;
typedef short bf16x8 __attribute__((ext_vector_type(8)));
typedef float f32x4 __attribute__((ext_vector_type(4)));
typedef unsigned u32x4 __attribute__((ext_vector_type(4)));
constexpr int BM = 256, BK = 64, HALF = 128, HTB = HALF * BK * 2  , STAGE_BYTES = 8 * HTB, NXCD = 8, WGM = 8;

__host__ __device__ __forceinline__ int lds_byte(int r, int c) { const int st = (r >> 4) * 2 + (c >> 5), rr = r & 15, cc = c & 31, ob = rr * 64 + cc * 2; return st * 1024 + (ob ^ (((ob >> 9) & 1) << 5)); }
__host__ __device__ __forceinline__ void stage_rc(int b, int& R, int& C) { const int st = b / 1024, sb = b % 1024, swz = sb ^ (((sb >> 9) & 1) << 5); R = (st >> 1) * 16 + swz / 64; C = (st & 1) * 32 + (swz % 64) / 2; }
__host__ __device__ __forceinline__ int perm32(int rho) { const int n = rho >> 4, i = rho & 15; return 8 * (i >> 2) + 4 * n + (i & 3); }

typedef int v8i32 __attribute__((ext_vector_type(8))); typedef int v4i32 __attribute__((ext_vector_type(4)));
__device__ __forceinline__ v8i32 pg8_cat(const bf16x8 lo, const bf16x8 hi) { const v4i32 a = __builtin_bit_cast(v4i32, lo), b = __builtin_bit_cast(v4i32, hi); return __builtin_shufflevector(a, b, 0, 1, 2, 3, 4, 5, 6, 7); }
template <int OFF> __device__ __forceinline__ void pg8_glds16(const char* sbase, unsigned voff, unsigned lds_base) { unsigned keep;
    asm volatile("s_mov_b32 %0, m0\n\ts_add_u32 m0, %3, %4\n\ts_nop 0\n\tglobal_load_lds_dwordx4 %1, %2\n\ts_mov_b32 m0, %0" : "=&s"(keep) : "v"(voff), "s"(sbase), "s"(lds_base), "i"(OFF) : "memory", "scc"); }
struct Unit { int pm, pn; };
struct Gemm { const bf16_t* A; const bf16_t* Bt; int M, N, K; };

struct StaticOrder {
    int nM, nN, nwg, G, c;
    __host__ __device__ void init(int M, int N, int G_, int c_) { nM = M / BM; nN = N / BM; nwg = nM * nN; G = G_; c = c_; }
    __host__ __device__ bool next(int i, Unit& u) const {
        const long L = (long)i * G + c; if (L >= nwg) return false;
        int wgid = (int)L; { const int q = nwg / NXCD, r = nwg % NXCD, xcd = wgid % NXCD, off = wgid / NXCD; wgid = (xcd < r ? xcd * (q + 1) : r * (q + 1) + (xcd - r) * q) + off; }
        const int nig = WGM * nN, gid = wgid / nig, fm = gid * WGM, gsz = (nM - fm) < WGM ? (nM - fm) : WGM;
        u.pm = fm + ((wgid % nig) % gsz); u.pn = (wgid % nig) / gsz; return true;
    }
    __device__ __forceinline__ size_t b_off(const Unit&) const { return 0; }
    __device__ __forceinline__ void a_ready(const Unit&) const {}
    __device__ __forceinline__ void done(const Unit&) const {}
};


typedef float f32x2 __attribute__((ext_vector_type(2)));
typedef __bf16 bf16x2_t __attribute__((ext_vector_type(2)));
__device__ __forceinline__ unsigned cvt_pk_bf16(float lo, float hi) { f32x2 v = {lo, hi}; bf16x2_t b = __builtin_convertvector(v, bf16x2_t); return __builtin_bit_cast(unsigned, b); }
__device__ __forceinline__ u32x4 pack8(const f32x4 v0, const f32x4 v1) { u32x4 w; w.x = cvt_pk_bf16(v0[0], v0[1]); w.y = cvt_pk_bf16(v0[2], v0[3]); w.z = cvt_pk_bf16(v1[0], v1[1]); w.w = cvt_pk_bf16(v1[2], v1[3]); return w; }

__device__ __forceinline__ float clamp448(float x) { return __builtin_fminf(__builtin_fmaxf(x, -448.f), 448.f); }
__device__ __forceinline__ unsigned cvt_fp8x4(float a, float b, float c, float d) { int w = __builtin_amdgcn_cvt_pk_fp8_f32(clamp448(a), clamp448(b), 0, false); w = __builtin_amdgcn_cvt_pk_fp8_f32(clamp448(c), clamp448(d), w, true); return (unsigned)w; }

struct EpiQKV {
    static constexpr bool PERM = true, AFTER_DRAIN = false;
    bf16_t* QKV; size_t tstride; const float* rcos; const float* rsin; float qscale; int rope_h0; int pn_off; int mode;
    __device__ __forceinline__ void operator()(const f32x4 (&acc)[2][2][4][2], const Unit& u, int wr, int wc, int fr, int fq) const {
        const int pnq = u.pn + pn_off, tsel = pnq >> 2, pq = pnq & 3;
        bf16_t* base = QKV + (size_t)tsel * tstride;
        const float sc = tsel == 0 ? qscale : 1.f;
        const int row0 = u.pm * BM + wr * 64 + fr, col0 = pq * BM + wc * 32 + 8 * fq;
        const bool ropew = (tsel < 2) && ((wc & 1) == 0) && (4 * pq + 2 + (wc >> 1) >= rope_h0) && !(mode & 2);
        const float pon = fq < 2 ? 1.f : 0.f, phase = (fq & 1) ? 0.f : 0.25f;
        constexpr float KF[8] = {1.591549431e-01f, 3.086376340e-02f, 5.985185713e-03f, 1.160663641e-03f, 2.250790790e-04f, 4.364795279e-05f, 8.464330808e-06f, 1.641426263e-06f};
#pragma unroll
        for (int ai = 0; ai < 2; ++ai)
#pragma unroll
            for (int m = 0; m < 4; ++m) {
                const int row = row0 + ai * HALF + m * 16;
                float ps[8], qc[8];
                if (ropew) { const float pf = (float)(row & 2047) * pon;
#pragma unroll
                    for (int j = 0; j < 8; ++j) { const float rev = __builtin_amdgcn_fractf(pf * KF[j] + phase); ps[j] = __builtin_amdgcn_sinf(rev); qc[j] = __builtin_amdgcn_cosf(rev); } }
                bf16_t* rowp = base + (size_t)row * 1024 + col0;
#pragma unroll
                for (int bj = 0; bj < 2; ++bj) {
                    f32x4 v0 = acc[ai][bj][m][0], v1 = acc[ai][bj][m][1];
                    const int head = 4 * pq + 2 * bj + (wc >> 1);
                    if (ropew && head >= rope_h0) {
#pragma unroll
                        for (int j = 0; j < 4; ++j) {
                            const unsigned a = __float_as_uint(v0[j]), b = __float_as_uint(v1[j]);
                            const auto ra = __builtin_amdgcn_permlane16_swap(a, a, false, false), rb = __builtin_amdgcn_permlane16_swap(b, b, false, false);
                            v0[j] = __uint_as_float(ra[0]) * ps[j] + __uint_as_float(ra[1]) * qc[j]; v1[j] = __uint_as_float(rb[0]) * ps[4 + j] + __uint_as_float(rb[1]) * qc[4 + j]; }
                    }
                    v0 = v0 * sc; v1 = v1 * sc;
                    if (!(mode & 1)) *(u32x4*)(rowp + bj * HALF) = pack8(v0, v1);
                }
            }
    }
};

template <bool BASE32> struct EpiRes {
    static constexpr bool PERM = true, AFTER_DRAIN = false;
    const void* base; bf16_t* out; int ldc;
    __device__ __forceinline__ void operator()(const f32x4 (&acc)[2][2][4][2], const Unit& u, int wr, int wc, int fr, int fq) const {
        const int row0 = u.pm * BM + wr * 64 + fr, col0 = u.pn * BM + wc * 32 + 8 * fq;
        constexpr int DEPTH = BASE32 ? 3 : 4;
        u32x4 b[DEPTH][BASE32 ? 4 : 2];
#define ER_OFF(g) ((size_t)(row0 + ((g) >> 2) * HALF + ((g) & 3) * 16) * ldc + col0)
#define ER_LOAD(g) do { if constexpr (BASE32) { const u32x4* bp = (const u32x4*)((const float*)base + ER_OFF(g)); b[(g) % DEPTH][0] = bp[0]; b[(g) % DEPTH][1] = bp[1]; b[(g) % DEPTH][2] = bp[HALF / 4]; b[(g) % DEPTH][3] = bp[HALF / 4 + 1]; } \
                        else { const bf16_t* bp = (const bf16_t*)base + ER_OFF(g); b[(g) % DEPTH][0] = *(const u32x4*)bp; b[(g) % DEPTH][1] = *(const u32x4*)(bp + HALF); } } while (0)
#pragma unroll
        for (int g = 0; g < DEPTH; ++g) ER_LOAD(g);
#pragma unroll
        for (int g = 0; g < 8; ++g) { const int ai = g >> 2, m = g & 3; u32x4 w[2];
#pragma unroll
            for (int bj = 0; bj < 2; ++bj) { f32x4 b0, b1;
                if constexpr (BASE32) { b0 = __builtin_bit_cast(f32x4, b[g % DEPTH][2 * bj]); b1 = __builtin_bit_cast(f32x4, b[g % DEPTH][2 * bj + 1]); }
                else { const u32x4 x = b[g % DEPTH][bj];
                    b0 = (f32x4){__uint_as_float(x.x << 16), __uint_as_float(x.x & 0xffff0000u), __uint_as_float(x.y << 16), __uint_as_float(x.y & 0xffff0000u)};
                    b1 = (f32x4){__uint_as_float(x.z << 16), __uint_as_float(x.z & 0xffff0000u), __uint_as_float(x.w << 16), __uint_as_float(x.w & 0xffff0000u)}; }
                w[bj] = pack8(b0 + acc[ai][bj][m][0], b1 + acc[ai][bj][m][1]); }
            asm volatile("" ::: "memory");
            *(u32x4*)(out + ER_OFF(g)) = w[0]; *(u32x4*)(out + ER_OFF(g) + HALF) = w[1];
            asm volatile("" ::: "memory");
            if (g + DEPTH < 8) ER_LOAD(g + DEPTH);
            asm volatile("" ::: "memory");
        }
#undef ER_LOAD
#undef ER_OFF
    }
};

template <bool OUT8> struct EpiSwiglu {
    static constexpr bool PERM = true, AFTER_DRAIN = false;
    void* H; int ldh; float hscale; int mode;
    __device__ __forceinline__ void hid(const f32x4 (&acc)[2][2][4][2], int ai, int m, f32x4 (&hv)[2]) const {
        const float rinv = __builtin_amdgcn_rcpf(hscale);
#pragma unroll
        for (int n = 0; n < 2; ++n) { const f32x4 g4 = acc[ai][0][m][n], u4 = acc[ai][1][m][n];
#pragma unroll
            for (int h = 0; h < 2; ++h) { const f32x2 g = {g4[2 * h], g4[2 * h + 1]}, up = {u4[2 * h], u4[2 * h + 1]};
                if (mode & 2) { const f32x2 s = (g + up) * hscale; hv[n][2 * h] = s.x; hv[n][2 * h + 1] = s.y; }
                else { const f32x2 t = g * -1.4426950408889634f; f32x2 e2 = {__builtin_amdgcn_exp2f(t.x), __builtin_amdgcn_exp2f(t.y)};
                    const f32x2 d = e2 * rinv + rinv; const f32x2 r = {__builtin_amdgcn_rcpf(d.x), __builtin_amdgcn_rcpf(d.y)};
                    const f32x2 o = (g * up) * r; hv[n][2 * h] = o.x; hv[n][2 * h + 1] = o.y; } } }
    }
    __device__ __forceinline__ void operator()(const f32x4 (&acc)[2][2][4][2], const Unit& u, int wr, int wc, int fr, int fq) const {
        const int row0 = u.pm * BM + wr * 64 + fr, col0 = u.pn * HALF + wc * 32 + 8 * fq;
        if constexpr (OUT8) {
            const int odd = fq & 1;
#pragma unroll
            for (int ai = 0; ai < 2; ++ai)
#pragma unroll
                for (int mp = 0; mp < 2; ++mp) {
                    f32x4 ha[2], hb[2]; hid(acc, ai, 2 * mp, ha); hid(acc, ai, 2 * mp + 1, hb);
                    const unsigned a0 = cvt_fp8x4(ha[0][0], ha[0][1], ha[0][2], ha[0][3]), a1 = cvt_fp8x4(ha[1][0], ha[1][1], ha[1][2], ha[1][3]);
                    const unsigned b0 = cvt_fp8x4(hb[0][0], hb[0][1], hb[0][2], hb[0][3]), b1 = cvt_fp8x4(hb[1][0], hb[1][1], hb[1][2], hb[1][3]);
                    const auto r0 = __builtin_amdgcn_permlane16_swap(a0, b0, false, false), r1 = __builtin_amdgcn_permlane16_swap(a1, b1, false, false);
                    u32x4 w; w.x = r0[0]; w.y = r1[0]; w.z = r0[1]; w.w = r1[1];
                    const size_t off = (size_t)(row0 + ai * HALF + (2 * mp + odd) * 16) * ldh + col0 - 8 * odd;
                    if (!(mode & 1)) *(u32x4*)((unsigned char*)H + off) = w;
                }
        } else {
#pragma unroll
            for (int ai = 0; ai < 2; ++ai)
#pragma unroll
                for (int m = 0; m < 4; ++m) { f32x4 hv[2]; hid(acc, ai, m, hv);
                    *(u32x4*)((bf16_t*)H + (size_t)(row0 + ai * HALF + m * 16) * ldh + col0) = pack8(hv[0], hv[1]); }
        }
    }
};

struct EpiY {
    static constexpr bool PERM = true, AFTER_DRAIN = false;
    unsigned char* Y; const float* gate; int row_base; float yscale;
    __device__ __forceinline__ void operator()(const f32x4 (&acc)[2][2][4][2], const Unit& u, int wr, int wc, int fr, int fq) const {
        const int row0 = row_base + u.pm * BM + wr * 64 + fr, col0 = u.pn * BM + wc * 32 + 8 * fq, odd = fq & 1;
        float gt[2][4];
#pragma unroll
        for (int ai = 0; ai < 2; ++ai)
#pragma unroll
            for (int m = 0; m < 4; ++m) gt[ai][m] = gate[row0 + ai * HALF + m * 16];
        asm volatile("" ::: "memory");
#pragma unroll
        for (int ai = 0; ai < 2; ++ai)
#pragma unroll
            for (int mp = 0; mp < 2; ++mp) { const int rowA = row0 + ai * HALF + (2 * mp) * 16, rowB = rowA + 16; const float ga = gt[ai][2 * mp] * yscale, gb = gt[ai][2 * mp + 1] * yscale;
                unsigned char* rowp = Y + (size_t)(odd ? rowB : rowA) * 1024 + col0 - 8 * odd;
#pragma unroll
                for (int bj = 0; bj < 2; ++bj) { const f32x4 a0v = acc[ai][bj][2 * mp][0] * ga, a1v = acc[ai][bj][2 * mp][1] * ga, b0v = acc[ai][bj][2 * mp + 1][0] * gb, b1v = acc[ai][bj][2 * mp + 1][1] * gb;
                    const unsigned a0 = cvt_fp8x4(a0v[0], a0v[1], a0v[2], a0v[3]), a1 = cvt_fp8x4(a1v[0], a1v[1], a1v[2], a1v[3]), b0 = cvt_fp8x4(b0v[0], b0v[1], b0v[2], b0v[3]), b1 = cvt_fp8x4(b1v[0], b1v[1], b1v[2], b1v[3]);
                    const auto r0 = __builtin_amdgcn_permlane16_swap(a0, b0, false, false), r1 = __builtin_amdgcn_permlane16_swap(a1, b1, false, false);
                    u32x4 w; w.x = r0[0]; w.y = r1[0]; w.z = r0[1]; w.w = r1[1];
                    *(u32x4*)(rowp + bj * HALF) = w; } }
    }
};

struct MoeOrder : StaticOrder {
    const PG8_LAS int* be_lds; size_t estride;
    __device__ __forceinline__ size_t b_off(const Unit& u) const { return (size_t)__builtin_amdgcn_readfirstlane(be_lds[u.pm]) * estride; }
};
template <class Epi, class Sched, bool ALIGN_EPI = false, bool SP2 = false, bool FP8 = false>
__device__ __forceinline__ void gemm_phase(PG8_LAS unsigned char* lds, const Gemm g, const Sched& S, const Epi& E, const int wave_id, const int sexp = 127) {
    const int wid = wave_id, tid = wave_id * 64 + fresh_lane(), lane = tid & 63, wr = wid >> 2, wc = wid & 3, fr = lane & 15, fq = lane >> 4;
    const int K = g.K, nt = K / BK; const int sexp_v = sexp * 0x01010101;
    unsigned voffA[2], voffB[2];
#pragma unroll
    for (int i = 0; i < 2; ++i) { int R, C; stage_rc(tid * 16 + i * 8192, R, C); const int Rb = Epi::PERM ? ((R & ~31) + perm32(R & 31)) : R;
        voffA[i] = (unsigned)(R * K + C) * 2u; voffB[i] = (unsigned)(Rb * K + C) * 2u; }
    const size_t kstep = (size_t)(BK * 2);
    const size_t hstep = (size_t)HALF * K * 2;
    const size_t tstep = 2 * hstep;
    const unsigned lds_wave = (unsigned)__builtin_amdgcn_readfirstlane((unsigned)(uintptr_t)lds + (unsigned)wid * 1024u); const unsigned ldsw = (unsigned)wid * 1024u;
    const int aoff = lds_byte(wr * 64 + fr, fq * 8), boff = lds_byte(wc * 32 + fr, fq * 8);
#define PG8_SA(b, h) (((b) * 2 + (h)) * HTB)
#define PG8_SB(b, h) ((4 + (b) * 2 + (h)) * HTB)
#define PG8_STAGE(bufoff, gbase, voff) do { if constexpr (FP8) { pg8_glds16<(bufoff)>((const char*)(gbase), (voff)[0], lds_wave); pg8_glds16<(bufoff) + 8192>((const char*)(gbase), (voff)[1], lds_wave); } \
        else { _Pragma("unroll") for (int _i = 0; _i < 2; ++_i) __builtin_amdgcn_global_load_lds((const unsigned*)((const char*)(gbase) + (voff)[_i]), (PG8_LAS unsigned*)(lds + (bufoff) + ldsw + _i * 8192), 16, 0, 0); } } while (0)
#define PG8_LDA(dst, b, h) do { if constexpr (FP8) { _Pragma("unroll") for (int m = 0; m < 4; ++m) { const v4i32 lo_ = *(const PG8_LAS v4i32*)(lds + PG8_SA(b, h) + aoff + m * 2048), hi_ = *(const PG8_LAS v4i32*)(lds + PG8_SA(b, h) + aoff + m * 2048 + 1024); dst##8[m] = __builtin_shufflevector(lo_, hi_, 0, 1, 2, 3, 4, 5, 6, 7); } } else { \
        _Pragma("unroll") for (int m = 0; m < 4; ++m) _Pragma("unroll") for (int k = 0; k < 2; ++k) dst[m][k] = *(const PG8_LAS bf16x8*)(lds + PG8_SA(b, h) + aoff + m * 2048 + k * 1024); } } while (0)
#define PG8_LDB(dst, b, h) do { if constexpr (FP8) { _Pragma("unroll") for (int n = 0; n < 2; ++n) { const v4i32 lo_ = *(const PG8_LAS v4i32*)(lds + PG8_SB(b, h) + boff + n * 2048), hi_ = *(const PG8_LAS v4i32*)(lds + PG8_SB(b, h) + boff + n * 2048 + 1024); dst##8[n] = __builtin_shufflevector(lo_, hi_, 0, 1, 2, 3, 4, 5, 6, 7); } } else { \
        _Pragma("unroll") for (int n = 0; n < 2; ++n) _Pragma("unroll") for (int k = 0; k < 2; ++k) dst[n][k] = *(const PG8_LAS bf16x8*)(lds + PG8_SB(b, h) + boff + n * 2048 + k * 1024); } } while (0)
#define PG8_MMA(ai, bj, At, Bt) do { __builtin_amdgcn_s_setprio(1); if constexpr (FP8) { _Pragma("unroll") for (int m = 0; m < 4; ++m) _Pragma("unroll") for (int n = 0; n < 2; ++n) \
        acc[ai][bj][m][n] = __builtin_amdgcn_mfma_scale_f32_16x16x128_f8f6f4(Bt##8[n], At##8[m], acc[ai][bj][m][n], 0, 0, 0, sexp_v, 0, 0x7f7f7f7f); } else { \
        _Pragma("unroll") for (int m = 0; m < 4; ++m) _Pragma("unroll") for (int n = 0; n < 2; ++n) _Pragma("unroll") for (int k = 0; k < 2; ++k) \
        acc[ai][bj][m][n] = __builtin_amdgcn_mfma_f32_16x16x32_bf16(Bt[n][k], At[m][k], acc[ai][bj][m][n], 0, 0, 0); } __builtin_amdgcn_s_setprio(0); } while (0)
#define PG8_WAIT_V(n) asm volatile("s_waitcnt vmcnt(" #n ")" ::: "memory")
#define PG8_WAIT_L(n) asm volatile("s_waitcnt lgkmcnt(" #n ")" ::: "memory")
#define PG8_BAR __builtin_amdgcn_s_barrier()
#define PG8_SCHED __builtin_amdgcn_sched_barrier(0)
    Unit cur, nxt; int ui = 0;
    if (!S.next(0, cur)) return;
    f32x4 acc[2][2][4][2];
#pragma unroll
    for (int a = 0; a < 2; ++a)
#pragma unroll
        for (int b = 0; b < 2; ++b)
#pragma unroll
            for (int m = 0; m < 4; ++m)
#pragma unroll
                for (int n = 0; n < 2; ++n) acc[a][b][m][n] = (f32x4){0.f, 0.f, 0.f, 0.f};
    bf16x8 At[4][2], B0[2][2], B1[2][2]; v8i32 At8[4], B08[2], B18[2];
    const char* cA = (const char*)g.A + (size_t)cur.pm * tstep; const char* cB = (const char*)g.Bt + S.b_off(cur) + (size_t)cur.pn * tstep;
    S.a_ready(cur);
    if constexpr (SP2) {
        PG8_STAGE(PG8_SB(0, 0), cB, voffB); PG8_STAGE(PG8_SB(0, 1), cB + hstep, voffB); PG8_STAGE(PG8_SA(0, 0), cA, voffA); PG8_STAGE(PG8_SA(0, 1), cA + hstep, voffA);
        if (wr == 1) PG8_BAR;
        PG8_WAIT_V(2); PG8_BAR;
        PG8_STAGE(PG8_SB(1, 0), cB + kstep, voffB); PG8_STAGE(PG8_SA(1, 0), cA + kstep, voffA); PG8_STAGE(PG8_SB(1, 1), cB + hstep + kstep, voffB);
        PG8_WAIT_V(6); PG8_BAR;
    } else {
        PG8_STAGE(PG8_SB(0, 0), cB, voffB); PG8_STAGE(PG8_SA(0, 0), cA, voffA); PG8_STAGE(PG8_SB(0, 1), cB + hstep, voffB); PG8_STAGE(PG8_SA(0, 1), cA + hstep, voffA);
        if (wr == 1) PG8_BAR;
        PG8_WAIT_V(4); PG8_BAR;
        PG8_STAGE(PG8_SB(1, 0), cB + kstep, voffB); PG8_STAGE(PG8_SA(1, 0), cA + kstep, voffA); PG8_STAGE(PG8_SB(1, 1), cB + hstep + kstep, voffB);
        PG8_WAIT_V(6); PG8_BAR;
    }
    for (;;) {
        const bool has_next = S.next(ui + 1, nxt);
        const char* nA = has_next ? (const char*)g.A + (size_t)nxt.pm * tstep : cA; const char* nB = has_next ? (const char*)g.Bt + S.b_off(nxt) + (size_t)nxt.pn * tstep : cB;
#pragma unroll 1
        for (int t = 0; t < nt; t += 2) {
            const bool last = (t == nt - 2);
            const char* a1 = cA + (size_t)(t + 1) * kstep;
            const char* a2 = last ? nA : cA + (size_t)(t + 2) * kstep; const char* b2 = last ? nB : cB + (size_t)(t + 2) * kstep;
            const char* a3 = a2 + kstep; const char* b3 = b2 + kstep;
            if (last && has_next) S.a_ready(nxt);
            if constexpr (SP2) {
            PG8_LDB(B0, 0, 0); PG8_LDB(B1, 0, 1); PG8_SCHED; PG8_LDA(At, 0, 0); PG8_STAGE(PG8_SA(1, 1), a1 + hstep, voffA);
            PG8_WAIT_V(8); PG8_WAIT_L(0); PG8_BAR; PG8_MMA(0, 0, At, B0); PG8_MMA(0, 1, At, B1); PG8_BAR; PG8_SCHED;
            PG8_LDA(At, 0, 1); PG8_STAGE(PG8_SB(0, 0), b2, voffB); PG8_STAGE(PG8_SB(0, 1), b2 + hstep, voffB); PG8_STAGE(PG8_SA(0, 0), a2, voffA);
            PG8_WAIT_V(8); PG8_WAIT_L(0); PG8_BAR; PG8_MMA(1, 0, At, B0); PG8_MMA(1, 1, At, B1); PG8_BAR; PG8_SCHED;
            PG8_LDB(B0, 1, 0); PG8_LDB(B1, 1, 1); PG8_SCHED; PG8_LDA(At, 1, 0); PG8_STAGE(PG8_SA(0, 1), a2 + hstep, voffA);
            PG8_WAIT_V(8); PG8_WAIT_L(0); PG8_BAR; PG8_MMA(0, 0, At, B0); PG8_MMA(0, 1, At, B1); PG8_BAR; PG8_SCHED;
            PG8_LDA(At, 1, 1); PG8_STAGE(PG8_SB(1, 0), b3, voffB); PG8_STAGE(PG8_SB(1, 1), b3 + hstep, voffB); PG8_STAGE(PG8_SA(1, 0), a3, voffA);
            PG8_WAIT_V(8); PG8_WAIT_L(0); PG8_BAR; PG8_MMA(1, 0, At, B0); PG8_MMA(1, 1, At, B1); PG8_BAR; PG8_SCHED;
            } else {
            PG8_LDB(B0, 0, 0); PG8_SCHED; PG8_LDA(At, 0, 0); PG8_STAGE(PG8_SA(1, 1), a1 + hstep, voffA);
            PG8_WAIT_L(8); PG8_BAR; PG8_WAIT_L(0); PG8_MMA(0, 0, At, B0); PG8_BAR; PG8_SCHED;
            PG8_LDB(B1, 0, 1); PG8_STAGE(PG8_SB(0, 0), b2, voffB);
            PG8_BAR; PG8_WAIT_L(0); PG8_MMA(0, 1, At, B1); PG8_BAR;
            PG8_LDA(At, 0, 1); PG8_STAGE(PG8_SA(0, 0), a2, voffA);
            PG8_BAR; PG8_WAIT_L(0); PG8_MMA(1, 0, At, B0); PG8_BAR; PG8_SCHED;
            PG8_STAGE(PG8_SB(0, 1), b2 + hstep, voffB);
            PG8_WAIT_V(6); PG8_BAR; PG8_MMA(1, 1, At, B1); PG8_BAR;
            PG8_LDB(B0, 1, 0); PG8_SCHED; PG8_LDA(At, 1, 0); PG8_STAGE(PG8_SA(0, 1), a2 + hstep, voffA);
            PG8_WAIT_L(8); PG8_BAR; PG8_WAIT_L(0); PG8_MMA(0, 0, At, B0); PG8_BAR; PG8_SCHED;
            PG8_LDB(B1, 1, 1); PG8_STAGE(PG8_SB(1, 0), b3, voffB);
            PG8_BAR; PG8_WAIT_L(0); PG8_MMA(0, 1, At, B1); PG8_BAR;
            PG8_LDA(At, 1, 1); PG8_STAGE(PG8_SA(1, 0), a3, voffA);
            PG8_BAR; PG8_WAIT_L(0); PG8_MMA(1, 0, At, B0); PG8_BAR; PG8_SCHED;
            PG8_STAGE(PG8_SB(1, 1), b3 + hstep, voffB);
            PG8_WAIT_V(6); PG8_BAR; PG8_MMA(1, 1, At, B1); PG8_BAR;
            }
        }
        if constexpr (ALIGN_EPI) { if (wr == 0) PG8_BAR; }
        if constexpr (!Epi::AFTER_DRAIN) { const int lane_e = fresh_lane();
            E(acc, cur, wr, wc, lane_e & 15, lane_e >> 4); S.done(cur); }
        if (!has_next) break;
#pragma unroll
        for (int a = 0; a < 2; ++a)
#pragma unroll
            for (int b = 0; b < 2; ++b)
#pragma unroll
                for (int m = 0; m < 4; ++m)
#pragma unroll
                    for (int n = 0; n < 2; ++n) acc[a][b][m][n] = (f32x4){0.f, 0.f, 0.f, 0.f};
        cur = nxt; cA = nA; cB = nB; ++ui;
        if constexpr (ALIGN_EPI) { if (wr == 1) PG8_BAR; }
    }
    PG8_WAIT_V(0);
    if constexpr (!ALIGN_EPI) { if (wr == 0) PG8_BAR; }
    PG8_BAR;
    if constexpr (Epi::AFTER_DRAIN) { E.fused(acc, cur, wr, wc, fr, fq, lds, wid, lane); S.done(cur); }
#undef PG8_SA
#undef PG8_SB
#undef PG8_STAGE
#undef PG8_LDA
#undef PG8_LDB
#undef PG8_MMA
#undef PG8_WAIT_V
#undef PG8_WAIT_L
#undef PG8_BAR
#undef PG8_SCHED
}
}

namespace att {
#define ATT_LAS __attribute__((address_space(3)))
using bf16x8 = __attribute__((ext_vector_type(8))) short;
using s16x4 = __attribute__((ext_vector_type(4))) short;
using f32x16 = __attribute__((ext_vector_type(16))) float;
using u32x4 = __attribute__((ext_vector_type(4))) unsigned;
typedef short v4i16_t __attribute__((ext_vector_type(4)));
typedef unsigned short bf16;
constexpr int SEQ = 2048, PITCH = 1024, NTOK = 32 * 2048;
constexpr int KSLOT = 9216, VSLOT = 8192;
constexpr int NSLOT = 3;
constexpr int L_K = 0, L_V = NSLOT * 2 * KSLOT, L_WS = L_V + NSLOT * 2 * VSLOT, L_OST = 0  , L_BYTES = L_WS + 8 * 256;
constexpr int LD_K = 0, LD_V = 6 * 8192, LD_WS = 12 * 8192, LD_OST = LD_WS + 8 * 256, LD_BYTES = LD_OST + 8 * 4096;
constexpr float C2 = 0.125f * 1.4426950408889634f;
constexpr float THR = 8.f;
enum { T_FOX = 0, T_MOBA = 1, T_D1 = 2, T_D4 = 3, T_D16 = 4 };
struct Tens { const bf16* Q; const bf16* K; const bf16* V; bf16* O; bf16* OX1; bf16* OX2; float* LSE; const u32x4* KAUG; const float* KMEAN; int mode; };

__device__ __forceinline__ int crow(int r, int hi) { return (r & 3) + 8 * (r >> 2) + 4 * hi; }
__device__ __forceinline__ void glds16s(const void* sbase, unsigned voff, unsigned lds_dst) { unsigned keep;
    asm volatile("s_mov_b32 %0, m0\n\ts_mov_b32 m0, %3\n\ts_nop 0\n\tglobal_load_lds_dwordx4 %1, %2\n\ts_mov_b32 m0, %0" : "=&s"(keep) : "v"(voff), "s"(sbase), "s"(lds_dst) : "memory"); }
typedef float f32x2_t __attribute__((ext_vector_type(2))); typedef __bf16 bf16x2_t __attribute__((ext_vector_type(2)));
__device__ __forceinline__ unsigned cvtpk_s(float lo, float hi) { f32x2_t v = {lo, hi}; bf16x2_t b = __builtin_convertvector(v, bf16x2_t); return __builtin_bit_cast(unsigned, b); }
__device__ __forceinline__ s16x4 vtr(const ATT_LAS char* p) { return __builtin_bit_cast(s16x4, __builtin_amdgcn_ds_read_tr16_b64_v4i16((ATT_LAS v4i16_t*)p)); }
#define ATT_MX3(a, b, c) __builtin_fmaxf(__builtin_fmaxf((a), (b)), (c))

template <bool AUG> __device__ __forceinline__ void qk_tile(f32x16& p0, f32x16& p1, const ATT_LAS char* kslot, const bf16x8 (&qr)[4], const f32x16& cinit, int r32, int hi) {
    const ATT_LAS char* kp = kslot + hi * 1024 + r32 * 16;
#pragma unroll
    for (int d0 = 0; d0 < 4; ++d0) {
        const bf16x8 b0 = *(const ATT_LAS bf16x8*)(kp + d0 * 2048), b1 = *(const ATT_LAS bf16x8*)(kp + d0 * 2048 + 512);
        if (d0 == 0) { p0 = __builtin_amdgcn_mfma_f32_32x32x16_bf16(b0, qr[0], cinit, 0, 0, 0); p1 = __builtin_amdgcn_mfma_f32_32x32x16_bf16(b1, qr[0], cinit, 0, 0, 0); }
        else { p0 = __builtin_amdgcn_mfma_f32_32x32x16_bf16(b0, qr[d0], p0, 0, 0, 0); p1 = __builtin_amdgcn_mfma_f32_32x32x16_bf16(b1, qr[d0], p1, 0, 0, 0); }
    }
    if (AUG) { const ATT_LAS char* ka = kslot + 8192 + r32 * 16;
        const bf16x8 a0_ = *(const ATT_LAS bf16x8*)(ka), a1_ = *(const ATT_LAS bf16x8*)(ka + 512);
        const short one = hi == 0 ? (short)0x3f80 : (short)0; const bf16x8 qaug = {one, one, one, 0, 0, 0, 0, 0};
        p0 = __builtin_amdgcn_mfma_f32_32x32x16_bf16(a0_, qaug, p0, 0, 0, 0); p1 = __builtin_amdgcn_mfma_f32_32x32x16_bf16(a1_, qaug, p1, 0, 0, 0); }
}
__device__ __forceinline__ void exp_pack(f32x16& p0, f32x16& p1, u32x4 (&pw)[4], float& l_reg) {
    float s0 = 0.f, s1 = 0.f;
#pragma unroll
    for (int r = 0; r < 16; ++r) { p0[r] = __builtin_amdgcn_exp2f(p0[r]); p1[r] = __builtin_amdgcn_exp2f(p1[r]); s0 += p0[r]; asm volatile("" : "+v"(s0)); s1 += p1[r]; asm volatile("" : "+v"(s1)); }
    l_reg += s0 + s1;
#pragma unroll
    for (int k = 0; k < 4; ++k) { pw[0][k] = cvtpk_s(p0[2 * k], p0[2 * k + 1]); pw[1][k] = cvtpk_s(p0[8 + 2 * k], p0[9 + 2 * k]); pw[2][k] = cvtpk_s(p1[2 * k], p1[2 * k + 1]); pw[3][k] = cvtpk_s(p1[8 + 2 * k], p1[9 + 2 * k]); }
}
__device__ __forceinline__ void pv_tile(f32x16 (&o)[2], const u32x4 (&pw)[4], const ATT_LAS char* vp) {
#pragma unroll
    for (int d0 = 0; d0 < 2; ++d0)
#pragma unroll
        for (int ks = 0; ks < 4; ++ks) { const s16x4 lo = vtr(vp + d0 * 4096 + ks * 1024), hh = vtr(vp + d0 * 4096 + ks * 1024 + 512);
            const bf16x8 vf = {lo[0], lo[1], lo[2], lo[3], hh[0], hh[1], hh[2], hh[3]};
            o[d0] = __builtin_amdgcn_mfma_f32_32x32x16_bf16(__builtin_bit_cast(bf16x8, pw[ks]), vf, o[d0], 0, 0, 0); }
}
struct St { float mhat, l_reg; f32x16 o[2]; f32x16 negm; u32x4 pw[4]; const ATT_LAS char* vprev; bool pend; };
__device__ __forceinline__ void st_init(St& s) { s.mhat = 0.f; s.l_reg = 0.f; s.o[0] = f32x16{}; s.o[1] = f32x16{}; s.negm = f32x16{}; s.vprev = nullptr; s.pend = false;
#pragma unroll
    for (int k = 0; k < 4; ++k) s.pw[k] = u32x4{0u, 0u, 0u, 0u}; }
template <bool AUG> __device__ __forceinline__ void tile_step(St& s, const ATT_LAS char* kslot, const ATT_LAS char* vslot_l, const bf16x8 (&qr)[4], bool lanesel, bool on, bool hi_act, bool lo_act, int dq,
                                                              ATT_LAS float* wsf, int r32, int hi, const int mode = 0) {
    f32x16 p0, p1;
    if (mode & 128) { p0 = s.negm; p1 = s.negm; }
    else if (lanesel && !__all(on)) { f32x16 cm;
#pragma unroll
        for (int r = 0; r < 16; ++r) cm[r] = on ? s.negm[r] : -INFINITY;
        qk_tile<AUG>(p0, p1, kslot, qr, cm, r32, hi); }
    else qk_tile<AUG>(p0, p1, kslot, qr, s.negm, r32, hi);
    if (s.pend && !(mode & 16)) pv_tile(s.o, s.pw, s.vprev);
    if (hi_act) {
#pragma unroll
        for (int r = 0; r < 16; ++r) { const int c = (r & 3) + 8 * (r >> 2); if (c > dq) p0[r] = -INFINITY; if (c + 32 > dq) p1[r] = -INFINITY; } }
    if (lo_act) { const int dl_ = dq - 128;
#pragma unroll
        for (int r = 0; r < 16; ++r) { const int c = (r & 3) + 8 * (r >> 2); if (c < dl_) p0[r] = -INFINITY; if (c + 32 < dl_) p1[r] = -INFINITY; } }
    float a = ATT_MX3(p0[0], p0[1], p1[0]), bq = ATT_MX3(p0[2], p0[3], p1[1]); a = ATT_MX3(a, p1[2], p1[3]);
#pragma unroll
    for (int r = 4; r < 16; r += 4) { a = ATT_MX3(a, p0[r], p0[r + 1]); bq = ATT_MX3(bq, p0[r + 2], p0[r + 3]); a = ATT_MX3(a, p1[r], p1[r + 1]); bq = ATT_MX3(bq, p1[r + 2], p1[r + 3]); }
    float rm = (mode & 64) ? 0.f : __builtin_fmaxf(a, bq);
    { auto rr = __builtin_amdgcn_permlane32_swap(__float_as_uint(rm), __float_as_uint(rm), false, false); rm = __builtin_fmaxf(__uint_as_float(rr[0]), __uint_as_float(rr[1])); }
    if (__any(rm > THR)) { const float dl = __builtin_fmaxf(rm, 0.f); s.mhat += dl;
#pragma unroll
        for (int r = 0; r < 16; ++r) { p0[r] -= dl; p1[r] -= dl; s.negm[r] = -s.mhat; }
        const float f = __builtin_amdgcn_exp2f(-dl); s.l_reg *= f; if (hi == 0) wsf[r32] = f;
#pragma unroll
        for (int r = 0; r < 16; ++r) { const float fr_ = wsf[crow(r, hi)]; s.o[0][r] *= fr_; s.o[1][r] *= fr_; } }
    if (!(mode & 8)) exp_pack(p0, p1, s.pw, s.l_reg); else { s.l_reg += p0[0] + p1[5]; }
    s.pend = true; s.vprev = vslot_l;
}
template <bool AUG, bool SEL> __device__ __forceinline__ void tile_step_steady(St& s, const ATT_LAS char* kslot, const ATT_LAS char* vslot_l, const bf16x8 (&qr)[4], bool on, ATT_LAS float* wsf, int r32, int hi,
                                                                        const bool hi_act = false, const bool lo_act = false, const int dq = 0) {
    f32x16 p0, p1;
    __builtin_amdgcn_s_setprio(1);
    if (SEL) { f32x16 cm;
#pragma unroll
        for (int r = 0; r < 16; ++r) cm[r] = on ? s.negm[r] : -INFINITY;
        qk_tile<AUG>(p0, p1, kslot, qr, cm, r32, hi); }
    else qk_tile<AUG>(p0, p1, kslot, qr, s.negm, r32, hi);
    __builtin_amdgcn_s_setprio(0);
    if (hi_act) {
#pragma unroll
        for (int r = 0; r < 16; ++r) { const int c = (r & 3) + 8 * (r >> 2); if (c > dq) p0[r] = -INFINITY; if (c + 32 > dq) p1[r] = -INFINITY; } }
    if (lo_act) { const int dl_ = dq - 128;
#pragma unroll
        for (int r = 0; r < 16; ++r) { const int c = (r & 3) + 8 * (r >> 2); if (c < dl_) p0[r] = -INFINITY; if (c + 32 < dl_) p1[r] = -INFINITY; } }
    float a = ATT_MX3(p0[0], p0[1], p1[0]), bq = ATT_MX3(p0[2], p0[3], p1[1]); a = ATT_MX3(a, p1[2], p1[3]);
#pragma unroll
    for (int r = 4; r < 16; r += 4) { a = ATT_MX3(a, p0[r], p0[r + 1]); bq = ATT_MX3(bq, p0[r + 2], p0[r + 3]); a = ATT_MX3(a, p1[r], p1[r + 1]); bq = ATT_MX3(bq, p1[r + 2], p1[r + 3]); }
    float rm = __builtin_fmaxf(a, bq);
    { auto rr = __builtin_amdgcn_permlane32_swap(__float_as_uint(rm), __float_as_uint(rm), false, false); rm = __builtin_fmaxf(__uint_as_float(rr[0]), __uint_as_float(rr[1])); }
    const bool resc = __any(rm > THR);
    if (__builtin_expect(resc, 0)) { const float dl = __builtin_fmaxf(rm, 0.f); s.mhat += dl;
#pragma unroll
        for (int r = 0; r < 16; ++r) { p0[r] -= dl; p1[r] -= dl; s.negm[r] = -s.mhat; }
        const float f = __builtin_amdgcn_exp2f(-dl); s.l_reg *= f; if (hi == 0) wsf[r32] = f; }
    const ATT_LAS char* vp = s.vprev;
    s16x4 vlo = vtr(vp), vhi = vtr(vp + 512);
    float s0 = 0.f, s1 = 0.f;
    __builtin_amdgcn_sched_barrier(0);
#pragma unroll
    for (int i = 0; i < 8; ++i) {
        s16x4 nlo = vlo, nhi = vhi;
        if (i < 7) { const int off = ((i + 1) >> 2) * 4096 + ((i + 1) & 3) * 1024; nlo = vtr(vp + off); nhi = vtr(vp + off + 512); }
        const bf16x8 vf = {vlo[0], vlo[1], vlo[2], vlo[3], vhi[0], vhi[1], vhi[2], vhi[3]};
        s.o[i >> 2] = __builtin_amdgcn_mfma_f32_32x32x16_bf16(__builtin_bit_cast(bf16x8, s.pw[i & 3]), vf, s.o[i >> 2], 0, 0, 0);
        if (i < 4) {
#pragma unroll
            for (int j = 0; j < 4; ++j) { p0[4 * i + j] = __builtin_amdgcn_exp2f(p0[4 * i + j]); s0 += p0[4 * i + j]; }
            asm volatile("" : "+v"(s0), "+v"(p0));
        } else {
#pragma unroll
            for (int j = 0; j < 4; ++j) { p1[4 * (i - 4) + j] = __builtin_amdgcn_exp2f(p1[4 * (i - 4) + j]); s1 += p1[4 * (i - 4) + j]; }
            asm volatile("" : "+v"(s1), "+v"(p1));
        }
        __builtin_amdgcn_sched_barrier(0);
        vlo = nlo; vhi = nhi;
    }
#pragma unroll
    for (int r = 0; r < 16; ++r) {   }
    s.l_reg += s0 + s1;
    if (__builtin_expect(resc, 0)) {
#pragma unroll
        for (int r = 0; r < 16; ++r) { const float fr_ = wsf[crow(r, hi)]; s.o[0][r] *= fr_; s.o[1][r] *= fr_; } }
#pragma unroll
    for (int k = 0; k < 4; ++k) { s.pw[0][k] = cvtpk_s(p0[2 * k], p0[2 * k + 1]); s.pw[1][k] = cvtpk_s(p0[8 + 2 * k], p0[9 + 2 * k]); s.pw[2][k] = cvtpk_s(p1[2 * k], p1[2 * k + 1]); s.pw[3][k] = cvtpk_s(p1[8 + 2 * k], p1[9 + 2 * k]); }
    s.vprev = vslot_l;
}
__device__ __forceinline__ void unit_finish(St& s, ATT_LAS float* wsf, ATT_LAS bf16* stg, bf16* Ob, int opitch, int qrow0, int kstr, float* lse_dst, int lane, int r32, int hi, const int mode) {
    if (s.pend) pv_tile(s.o, s.pw, s.vprev);
    float l_reg = s.l_reg;
    { auto rr = __builtin_amdgcn_permlane32_swap(__float_as_uint(l_reg), __float_as_uint(l_reg), false, false); l_reg = __uint_as_float(rr[0]) + __uint_as_float(rr[1]); }
    if (hi == 0) wsf[32 + r32] = l_reg;
    if (lse_dst != nullptr && hi == 0 && !(mode & 1)) *lse_dst = s.mhat + __builtin_amdgcn_logf(l_reg);
#pragma unroll
    for (int r = 0; r < 16; ++r) { const int orow = crow(r, hi); const float rl = __builtin_amdgcn_rcpf(wsf[32 + orow]);
        const unsigned w = cvtpk_s(s.o[0][r] * rl, s.o[1][r] * rl);
        stg[orow * 64 + r32] = (bf16)(w & 0xffffu); stg[orow * 64 + 32 + r32] = (bf16)(w >> 16); }
#pragma unroll
    for (int i = 0; i < 4; ++i) { const int row = i * 8 + (lane >> 3), ch = lane & 7; const u32x4 v = *(const ATT_LAS u32x4*)(stg + row * 64 + ch * 8);
        if (!(mode & 1)) *(u32x4*)(Ob + (long)(qrow0 + row * kstr) * opitch + ch * 8) = v; }
}

template <bool AUG> __device__ __forceinline__ int ring_kidx(int a0, int t) { if (AUG) return 64 * t; return 64 * (t < 4 ? 4 * a0 + t : t - 4); }
template <bool AUG>
__device__ __forceinline__ void unit_ring(const int b, const int h, const int a0, const Tens& T, ATT_LAS char* shm, const int wid) {
    const int lane = fresh_lane(), r32 = lane & 31, hi = lane >> 5;
    const int rb = b * SEQ, NT = 4 * a0 + 4, qmin = 256 * a0 + 32 * wid, qmax = qmin + 31, qrow0 = rb + qmin, qrow = qrow0 + r32;
    const unsigned lds0 = (unsigned)(uintptr_t)shm;
    ATT_LAS float* wsf = (ATT_LAS float*)(shm + L_WS) + wid * 64;
    const bf16* Kh = T.K + (long)rb * PITCH + h * 64; const bf16* Vh = T.V + (long)rb * PITCH + h * 64;
    const unsigned voff_k = (unsigned)(lane * PITCH + wid * 8) * 2u, voff_v = (unsigned)((16 * (wid & 3) + (lane >> 2)) * PITCH + (wid >> 2) * 32 + (lane & 3) * 8) * 2u;
#define ATT_ISSUE1(t_, sub_) do { const int kidx_ = ring_kidx<AUG>(a0, (t_)); \
        if (AUG && wid == 7) glds16s(T.KAUG + ((long)(b * 5 + h) * SEQ + kidx_), (unsigned)lane * 16u, (unsigned)__builtin_amdgcn_readfirstlane(lds0 + L_K + (sub_) * KSLOT + 8192)); \
        glds16s(Kh + (long)kidx_ * PITCH, voff_k, (unsigned)__builtin_amdgcn_readfirstlane(lds0 + L_K + (sub_) * KSLOT + wid * 1024)); \
        glds16s(Vh + (long)kidx_ * PITCH, voff_v, (unsigned)__builtin_amdgcn_readfirstlane(lds0 + L_V + (sub_) * VSLOT + wid * 1024)); } while (0)
#define ATT_ISSUE(pair_, pslot_) do { ATT_ISSUE1(2 * (pair_), 2 * (pslot_)); ATT_ISSUE1(2 * (pair_) + 1, 2 * (pslot_) + 1); } while (0)
    bf16x8 qr[4];
    { const bf16* Qw = T.Q + (long)qrow * PITCH + h * 64 + hi * 8;
#pragma unroll
      for (int d0 = 0; d0 < 4; ++d0) qr[d0] = *reinterpret_cast<const bf16x8*>(Qw + d0 * 16); }
    ATT_ISSUE(0, 0);
    unsigned sel = 0xffu;
    if (!AUG && a0 > 3) {
        float gate[7];
        const float* km = T.KMEAN + (long)((b * 5 + (h - 5)) * 8) * 64 + hi * 8;
#pragma unroll
        for (int n = 0; n < 7; ++n) { float g = 0.f;
            if (n < a0) {
#pragma unroll
                for (int d0 = 0; d0 < 4; ++d0) {
                    const float4 k0 = *(const float4*)(km + n * 64 + d0 * 16), k1 = *(const float4*)(km + n * 64 + d0 * 16 + 4);
                    const bf16x8 qv = qr[d0];
#define ATT_QF(j) __uint_as_float(((unsigned)(unsigned short)qv[j]) << 16)
                    g += ATT_QF(0) * k0.x + ATT_QF(1) * k0.y + ATT_QF(2) * k0.z + ATT_QF(3) * k0.w + ATT_QF(4) * k1.x + ATT_QF(5) * k1.y + ATT_QF(6) * k1.z + ATT_QF(7) * k1.w;
#undef ATT_QF
                }
                g += __shfl_xor(g, 32);
            }
            gate[n] = g; }
        sel = 0u;
#pragma unroll
        for (int k = 0; k < 3; ++k) { float best = -INFINITY; unsigned bi = 0u;
#pragma unroll
            for (int n = 0; n < 7; ++n) { const bool ok = (n < a0) && !((sel >> n) & 1u) && (gate[n] > best); best = ok ? gate[n] : best; bi = ok ? (unsigned)n : bi; }
            sel |= 1u << bi; }
    }
    const ATT_LAS char* shmc = (const ATT_LAS char*)shm;
    const ATT_LAS char* vpl = shmc + L_V + ((lane >> 4) & 1) * 32 + (lane & 3) * 8 + (4 * hi + ((lane & 15) >> 2)) * 64;
    St s; st_init(s); s.vprev = vpl;
    asm volatile("" : "+v"(qr[0]), "+v"(qr[1]), "+v"(qr[2]), "+v"(qr[3]));
    int slot = 0, islot = 1;
    const int ebase = qmin + r32 - 4 * hi, NP = NT / 2;
#define ATT_HEAD asm volatile("s_waitcnt vmcnt(0) lgkmcnt(0)\n\ts_barrier" ::: "memory")
#define ATT_ADV do { islot = (islot + 1 == NSLOT) ? 0 : islot + 1; slot = (slot + 1 == NSLOT) ? 0 : slot + 1; } while (0)
#define ATT_GEN_TILE(t, sub_) do { \
        const int kidx = ring_kidx<AUG>(a0, (t)); \
        const bool past = !AUG && (t) >= 4; \
        const bool need = past || (kidx <= qmax); \
        if (need) { if (past) tile_step_steady<AUG, true>(s, shmc + L_K + (sub_) * KSLOT, vpl + (sub_) * VSLOT, qr, ((sel >> (((t) - 4) >> 2)) & 1u) != 0u, wsf, r32, hi); \
                    else tile_step_steady<AUG, false>(s, shmc + L_K + (sub_) * KSLOT, vpl + (sub_) * VSLOT, qr, true, wsf, r32, hi, kidx + 63 > qmin, false, ebase - kidx); } \
        else { pv_tile(s.o, s.pw, s.vprev); _Pragma("unroll") for (int k_ = 0; k_ < 4; ++k_) s.pw[k_] = u32x4{0u, 0u, 0u, 0u}; }     \
        } while (0)
#define ATT_GEN_PAIR(i) do { ATT_HEAD; if ((i) + 1 < NP) ATT_ISSUE((i) + 1, islot); ATT_GEN_TILE(2 * (i), 2 * slot); ATT_GEN_TILE(2 * (i) + 1, 2 * slot + 1); ATT_ADV; } while (0)
#define ATT_STEADY_PAIR(i, SEL_) do { ATT_HEAD; ATT_ISSUE((i) + 1, islot); \
        tile_step_steady<AUG, SEL_>(s, shmc + L_K + (2 * slot) * KSLOT, vpl + (2 * slot) * VSLOT, qr, SEL_ ? (((sel >> ((2 * (i) - 4) >> 2)) & 1u) != 0u) : true, wsf, r32, hi); \
        tile_step_steady<AUG, SEL_>(s, shmc + L_K + (2 * slot + 1) * KSLOT, vpl + (2 * slot + 1) * VSLOT, qr, SEL_ ? (((sel >> ((2 * (i) + 1 - 4) >> 2)) & 1u) != 0u) : true, wsf, r32, hi); \
        ATT_ADV; } while (0)
    if (AUG) {
        int i = 0;
        if (NP > 2) {
#pragma unroll 1
            for (; i < NP - 2; ++i) ATT_STEADY_PAIR(i, false); }
#pragma unroll 1
        for (; i < NP; ++i) ATT_GEN_PAIR(i);
    } else {
        int i = 0;
#pragma unroll 1
        for (; i < 2; ++i) ATT_GEN_PAIR(i);
        if (NP - 1 > 2) {
#pragma unroll 1
            for (; i < NP - 1; ++i) ATT_STEADY_PAIR(i, true); }
#pragma unroll 1
        for (; i < NP; ++i) ATT_GEN_PAIR(i);
    }
#undef ATT_GEN_TILE
#undef ATT_GEN_PAIR
#undef ATT_STEADY_PAIR
#undef ATT_HEAD
#undef ATT_ADV
    pv_tile(s.o, s.pw, s.vprev); s.pend = false;
    asm volatile("s_waitcnt lgkmcnt(0)\n\ts_barrier" ::: "memory");
    unit_finish(s, wsf, (ATT_LAS bf16*)(shm + L_OST) + wid * 2048, T.O + h * 64, PITCH, qrow0, 1, nullptr, lane, r32, hi, T.mode);
    asm volatile("s_waitcnt lgkmcnt(0)\n\ts_barrier" ::: "memory");
#undef ATT_ISSUE
#undef ATT_ISSUE1
}

__device__ __forceinline__ void unit_win(const int type, const int b, const int h, const int a0, const int a1, const Tens& T, ATT_LAS char* shm, const int wid) {
    const int lane = fresh_lane(), r32 = lane & 31, hi = lane >> 5;
    const int rb = b * SEQ;
    int qmin, kstr, rofs, ntl, tw0, ntw;
    if (type == T_D1) { qmin = 256 * a0 + 32 * wid; kstr = 1; rofs = 0; ntl = 6; tw0 = wid >> 1; ntw = 3; }
    else if (type == T_D4) { qmin = 256 * a0 + 32 * wid; kstr = 4; rofs = a1; ntl = 6; tw0 = wid >> 1; ntw = 3; }
    else { qmin = 32 * (wid & 3); kstr = 16; rofs = 2 * a0 + (wid >> 2); ntl = 4; tw0 = 2 * (wid >> 2); ntw = 2; }
    const int qmax = qmin + 31, qrow0 = rb + qmin * kstr + rofs, qrow = qrow0 + r32 * kstr;
    const unsigned lds0 = (unsigned)(uintptr_t)shm;
    ATT_LAS float* wsf = (ATT_LAS float*)(shm + LD_WS) + wid * 64;
    const bf16* Kh = T.K + (long)rb * PITCH + h * 64; const bf16* Vh = T.V + (long)rb * PITCH + h * 64;
    const unsigned voff_k = (unsigned)((lane * kstr) * PITCH + wid * 8) * 2u, voff_v = (unsigned)(((16 * (wid & 3) + (lane >> 2)) * kstr) * PITCH + (wid >> 2) * 32 + (lane & 3) * 8) * 2u;
    bf16x8 qr[4];
    { const bf16* Qw = T.Q + (long)qrow * PITCH + h * 64 + hi * 8;
#pragma unroll
      for (int d0 = 0; d0 < 4; ++d0) qr[d0] = *reinterpret_cast<const bf16x8*>(Qw + d0 * 16); }
    for (int t = 0; t < ntl; ++t) {
        int kidx, row0;
        if (type == T_D16) { kidx = 64 * (t & 1); row0 = 16 * kidx + 2 * a0 + (t >> 1); } else { kidx = 256 * a0 - 128 + 64 * t; row0 = kstr * kidx + rofs; }
        if (kidx >= 0 && !(T.mode & 4)) { glds16s(Kh + (long)row0 * PITCH, voff_k, (unsigned)__builtin_amdgcn_readfirstlane(lds0 + LD_K + t * 8192 + wid * 1024));
                         glds16s(Vh + (long)row0 * PITCH, voff_v, (unsigned)__builtin_amdgcn_readfirstlane(lds0 + LD_V + t * 8192 + wid * 1024)); }
    }
    St s; st_init(s);
    const ATT_LAS char* shmc = (const ATT_LAS char*)shm;
    const ATT_LAS char* vpl = shmc + LD_V + ((lane >> 4) & 1) * 32 + (lane & 3) * 8 + (4 * hi + ((lane & 15) >> 2)) * 64;
    asm volatile("" : "+v"(qr[0]), "+v"(qr[1]), "+v"(qr[2]), "+v"(qr[3]));
    asm volatile("s_waitcnt vmcnt(0) lgkmcnt(0)\n\ts_barrier" ::: "memory");
    const int ebase = qmin + r32 - 4 * hi;
    for (int i = (T.mode & 512) ? ntw : 0; i < ntw; ++i) {
        const int t = tw0 + i;
        const int kidx = (type == T_D16) ? 64 * (t & 1) : 256 * a0 - 128 + 64 * t;
        const bool need = (kidx >= 0) && (kidx <= qmax) && !(T.mode & 2);
        if (need) tile_step<false>(s, shmc + LD_K + t * 8192, vpl + t * 8192, qr, false, true, kidx + 63 > qmin, kidx < qmax - 128, ebase - kidx, wsf, r32, hi, T.mode);
    }
    bf16* Ob; int opitch;
    if (type == T_D1) { Ob = T.O + h * 64; opitch = PITCH; } else if (type == T_D4) { Ob = T.OX1 + (h - 10) * 64; opitch = 384; } else { Ob = T.OX2 + (h - 10) * 64; opitch = 384; }
    unit_finish(s, wsf, (ATT_LAS bf16*)(shm + LD_OST) + wid * 2048, Ob, opitch, qrow0, kstr, T.LSE + ((long)(type - T_D1) * NTOK + qrow) * 6 + (h - 10), lane, r32, hi, T.mode);
    asm volatile("s_waitcnt lgkmcnt(0)\n\ts_barrier" ::: "memory");
}
struct WinP { int type, b, h, a0, a1; };
__device__ __forceinline__ WinP win_decode(int u, int x) { WinP p; const int bh = (u / 24) * 8 + x, k = u % 24; p.b = bh / 6; p.h = 10 + bh % 6; p.a1 = 0;
    if (k < 8) { p.type = T_D1; p.a0 = k; } else if (k < 16) { p.type = T_D4; p.a0 = (k - 8) >> 2; p.a1 = (k - 8) & 3; } else { p.type = T_D16; p.a0 = k - 16; } return p; }
struct WinW { int qmin, kstr, rofs, ntl, tw0, ntw; };
__device__ __forceinline__ WinW win_wave(const WinP& p, int wid) { WinW w;
    if (p.type == T_D1) { w.qmin = 256 * p.a0 + 32 * wid; w.kstr = 1; w.rofs = 0; w.ntl = 6; w.tw0 = wid >> 1; w.ntw = 3; }
    else if (p.type == T_D4) { w.qmin = 256 * p.a0 + 32 * wid; w.kstr = 4; w.rofs = p.a1; w.ntl = 6; w.tw0 = wid >> 1; w.ntw = 3; }
    else { w.qmin = 32 * (wid & 3); w.kstr = 16; w.rofs = 2 * p.a0 + (wid >> 2); w.ntl = 4; w.tw0 = 2 * (wid >> 2); w.ntw = 2; }
    return w; }
__device__ __forceinline__ void win_request(const WinP& p, const WinW& w, const Tens& T, unsigned lds0, int wid, int lane, int r32, int hi, bf16x8 (&q)[4]) {
    const int rb = p.b * SEQ, qrow = rb + (w.qmin + r32) * w.kstr + w.rofs;
    const bf16* Kh = T.K + (long)rb * PITCH + p.h * 64; const bf16* Vh = T.V + (long)rb * PITCH + p.h * 64;
    const unsigned voff_k = (unsigned)((lane * w.kstr) * PITCH + wid * 8) * 2u, voff_v = (unsigned)(((16 * (wid & 3) + (lane >> 2)) * w.kstr) * PITCH + (wid >> 2) * 32 + (lane & 3) * 8) * 2u;
    { const bf16* Qw = T.Q + (long)qrow * PITCH + p.h * 64 + hi * 8;
#pragma unroll
      for (int d0 = 0; d0 < 4; ++d0) q[d0] = *reinterpret_cast<const bf16x8*>(Qw + d0 * 16); }
    for (int t = 0; t < w.ntl; ++t) {
        int kidx, row0;
        if (p.type == T_D16) { kidx = 64 * (t & 1); row0 = 16 * kidx + 2 * p.a0 + (t >> 1); } else { kidx = 256 * p.a0 - 128 + 64 * t; row0 = w.kstr * kidx + w.rofs; }
        if (kidx >= 0) { glds16s(Kh + (long)row0 * PITCH, voff_k, (unsigned)__builtin_amdgcn_readfirstlane(lds0 + LD_K + t * 8192 + wid * 1024));
                         glds16s(Vh + (long)row0 * PITCH, voff_v, (unsigned)__builtin_amdgcn_readfirstlane(lds0 + LD_V + t * 8192 + wid * 1024)); }
    }
}
__device__ __forceinline__ void win_units(const int u0, const int ustride, const int n, const int x, const Tens& T, ATT_LAS char* shm, const int wid) {
    if (n <= 0) return;
    const int lane = fresh_lane(), r32 = lane & 31, hi = lane >> 5;
    const unsigned lds0 = (unsigned)(uintptr_t)shm;
    ATT_LAS float* wsf = (ATT_LAS float*)(shm + LD_WS) + wid * 64;
    const ATT_LAS char* shmc = (const ATT_LAS char*)shm;
    const ATT_LAS char* vpl = shmc + LD_V + ((lane >> 4) & 1) * 32 + (lane & 3) * 8 + (4 * hi + ((lane & 15) >> 2)) * 64;
    WinP p = win_decode(u0, x); WinW w = win_wave(p, wid);
    bf16x8 qr[4];
    win_request(p, w, T, lds0, wid, lane, r32, hi, qr);
#pragma unroll 1
    for (int idx = 0; idx < n; ++idx) {
        asm volatile("" : "+v"(qr[0]), "+v"(qr[1]), "+v"(qr[2]), "+v"(qr[3]));
        asm volatile("s_waitcnt vmcnt(0) lgkmcnt(0)\n\ts_barrier" ::: "memory");
        St s; st_init(s); s.vprev = vpl + (p.type == T_D16 ? 3 : 5) * 8192;
        const int qmax = w.qmin + 31, ebase = w.qmin + r32 - 4 * hi;
        for (int i = 0; i < w.ntw; ++i) {
            const int t = w.tw0 + i;
            const int kidx = (p.type == T_D16) ? 64 * (t & 1) : 256 * p.a0 - 128 + 64 * t;
            const bool need = (kidx >= 0) && (kidx <= qmax);
            if (need) tile_step_steady<false, false>(s, shmc + LD_K + t * 8192, vpl + t * 8192, qr, true, wsf, r32, hi, kidx + 63 > w.qmin, kidx < qmax - 128, ebase - kidx);
        }
        pv_tile(s.o, s.pw, s.vprev); s.pend = false;
        asm volatile("s_waitcnt lgkmcnt(0)\n\ts_barrier" ::: "memory");
        const WinP pc = p; const WinW wc = w;
        if (idx + 1 < n) { p = win_decode(u0 + (idx + 1) * ustride, x); w = win_wave(p, wid); }
        bf16x8 qn[4] = {qr[0], qr[1], qr[2], qr[3]};
        if (idx + 1 < n) win_request(p, w, T, lds0, wid, lane, r32, hi, qn);
        const int rbc = pc.b * SEQ, qrow0 = rbc + wc.qmin * wc.kstr + wc.rofs, qrow = qrow0 + r32 * wc.kstr;
        bf16* Ob; int opitch;
        if (pc.type == T_D1) { Ob = T.O + pc.h * 64; opitch = PITCH; } else if (pc.type == T_D4) { Ob = T.OX1 + (pc.h - 10) * 64; opitch = 384; } else { Ob = T.OX2 + (pc.h - 10) * 64; opitch = 384; }
        unit_finish(s, wsf, (ATT_LAS bf16*)(shm + LD_OST) + wid * 2048, Ob, opitch, qrow0, wc.kstr, T.LSE + ((long)(pc.type - T_D1) * NTOK + qrow) * 6 + (pc.h - 10), lane, r32, hi, 0);
#pragma unroll
        for (int d0 = 0; d0 < 4; ++d0) qr[d0] = qn[d0];
    }
    asm volatile("s_waitcnt lgkmcnt(0)\n\ts_barrier" ::: "memory");
}
#undef ATT_MX3
}

constexpr int NWAVES = 8;
#ifndef PG8_ALIGN
#define PG8_ALIGN true
#endif
#ifndef PG8_SP2
#define PG8_SP2 true
#endif
#ifndef DENSE_FP8
#define DENSE_FP8 1
#endif
#ifndef MK_ONE_LAUNCH
#define MK_ONE_LAUNCH 1
#endif
constexpr int BATCH = 32, SEQ = 2048, D = 1024, NTOK = BATCH * SEQ, FF = 3584, NEXP = 8, WIN_LD = 3 * D + 5;
constexpr float EPS = 1e-6f;
constexpr int NRB = NTOK / 256;
constexpr int MAXBLK = 520;
constexpr int CHUNK_BLK = 256, NCHUNK = 3;
enum { PH_PRO = 0, PH_QKV0, PH_PRE0, PH_ATT0, PH_MIX0, PH_WO0, PH_N2_0, PH_UP0, PH_DN0,
       PH_N1_1, PH_QKV1, PH_PRE1, PH_ATT1, PH_MIX1, PH_WO1, PH_N2_1, PH_SCAT, PH_MOE0, PH_FINAL = PH_MOE0 + 2 * NCHUNK, PH_COUNT };
constexpr size_t MiB = 1u << 20;
constexpr size_t WS_CTL = 0, CTL_ZERO_BYTES = 1 * MiB;
constexpr size_t WS_WIN0 = 2 * MiB, WS_WOUT0 = 8 * MiB, WS_W13_0 = 10 * MiB, WS_W2_0 = 24 * MiB;
constexpr size_t WS_WIN1 = 32 * MiB, WS_WOUT1 = 38 * MiB, WS_W13E = 40 * MiB, WS_W2E = 152 * MiB;
constexpr size_t WS_RCOS = 208 * MiB, WS_RSIN = WS_RCOS + 65536, WS_LF = 209 * MiB, WS_KMEAN = 210 * MiB + 512 * 1024, WS_KAUG = 211 * MiB;
constexpr size_t WS_TOKE = 216 * MiB, WS_TOKG = WS_TOKE + 256 * 1024, WS_TOKS = WS_TOKG + 512 * 1024, WS_HIST = WS_TOKS + 512 * 1024, WS_META = WS_HIST + 16384, WS_BLKE = WS_META + 4096;
constexpr size_t WS_ROWG = 218 * MiB, WS_LSE = 219 * MiB;
constexpr size_t WS_HB = 224 * MiB;
constexpr size_t WS_Q = 354 * MiB, WS_K = 482 * MiB, WS_V = 610 * MiB, WS_OX1 = 738 * MiB, WS_OX2 = 786 * MiB;
constexpr size_t WS_HB8 = 738 * MiB;
constexpr size_t WS_WV8_OFF = 4 * MiB;
constexpr size_t WS_H = 354 * MiB;
constexpr size_t WS_XG = 354 * MiB, WS_Y = 484 * MiB, WS_HCH = 614 * MiB, WS_XR = 840 * MiB;
constexpr size_t WS_END = 968 * MiB;
static_assert(WS_V - WS_K == WS_K - WS_Q, "Q | K | V equally spaced");
static_assert(WS_W2E + 8 * 7 * MiB <= WS_RCOS && WS_KAUG + 160 * 2048 * 16 <= WS_TOKE && WS_BLKE + 4096 <= WS_ROWG && WS_ROWG + MAXBLK * 256 * 4 <= WS_LSE && WS_LSE + 3 * (size_t)NTOK * 6 * 4 <= WS_HB, "ws map 1");
static_assert(WS_HB + (size_t)(NTOK + 1) * D * 2 <= WS_Q && WS_OX2 + (size_t)NTOK * 384 * 2 <= WS_END && WS_H + (size_t)NTOK * FF * 2 <= WS_END && WS_XG + (size_t)MAXBLK * 256 * D <= WS_Y && WS_Y + (size_t)MAXBLK * 256 * D <= WS_HCH && WS_HCH + (size_t)CHUNK_BLK * 256 * FF <= WS_XR && WS_OX2 + (size_t)NTOK * 384 * 2 <= WS_XR && WS_XR + (size_t)NTOK * D * 2 <= WS_END, "ws map 2");
constexpr int CW_BAR = 4096;
constexpr int CW_AQ0 = 8192, CW_AQ1 = 8256;
constexpr int RING_OFF = 0, RING_BYTES = 135168, LDSCTL_OFF = RING_BYTES, MISC_OFF = LDSCTL_OFF + 320, LDSX_OFF = RING_BYTES + 1024, LDS_BYTES = 147456;
static_assert(att::L_BYTES <= RING_BYTES && att::LD_BYTES <= RING_BYTES && pg8::STAGE_BYTES <= RING_BYTES && LDSX_OFF + 8192 <= LDS_BYTES, "LDS map");

#define GAS __attribute__((address_space(1)))
#define LAS __attribute__((address_space(3)))
typedef unsigned short bf16;
typedef unsigned v4u __attribute__((ext_vector_type(4)));
typedef unsigned v2u __attribute__((ext_vector_type(2)));
typedef float f32x4 __attribute__((ext_vector_type(4)));
#define RLX_AGENT __ATOMIC_RELAXED, __HIP_MEMORY_SCOPE_AGENT
#define LDS_WAIT() asm volatile("s_waitcnt lgkmcnt(0)" ::: "memory")
#ifndef STG_QKV
#define STG_QKV 0
#endif
#ifndef STG_WO
#define STG_WO 0
#endif
#ifndef STG_UP
#define STG_UP 0
#endif
#ifndef STG_DN
#define STG_DN 0
#endif
#ifndef STG_MUP
#define STG_MUP 0
#endif
#ifndef STG_MDN
#define STG_MDN 0
#endif
#ifndef CLKP
#define CLKP -1
#endif
struct ClkStamp { unsigned long long t, r; };
__device__ __forceinline__ ClkStamp clk_begin() { ClkStamp s; s.t = __builtin_amdgcn_s_memtime(); s.r = __builtin_amdgcn_s_memrealtime(); return s; }
__device__ __forceinline__ void clk_end(const ClkStamp& s) { if (blockIdx.x == 0) { const unsigned long long t1 = __builtin_amdgcn_s_memtime(), r1 = __builtin_amdgcn_s_memrealtime();
    const unsigned long long mhz = (t1 - s.t) * 100ull / (r1 - s.r); while (__builtin_amdgcn_s_memrealtime() - r1 < mhz * 100ull) __builtin_amdgcn_s_sleep(8); } }
__device__ __forceinline__ void stagger(int steps) { const int n = steps * (int)((blockIdx.x >> 3) & 3); for (int i = 0; i < n; ++i) __builtin_amdgcn_s_sleep(32); }
__device__ __forceinline__ unsigned pk2(float lo, float hi) { return pg8::cvt_pk_bf16(lo, hi); }
__device__ __forceinline__ float bf_lo(unsigned w) { return __uint_as_float(w << 16); }
__device__ __forceinline__ float bf_hi(unsigned w) { return __uint_as_float(w & 0xffff0000u); }
__device__ __forceinline__ float wave_sum(float v) {
#pragma unroll
    for (int o = 1; o < 64; o <<= 1) v += __shfl_xor(v, o);
    return v;
}

#define XB_TMO      128
#define XB_XCNT(j)  (256  + 64 * (j))
#define XB_XSUB(j)  (1280 + 64 * (j))
#define XB_XGEN(j)  (2304 + 64 * (j))
#define XB_TOP      3328
#define XB_TOPGEN   3392
#define XCD_BAR_WORDS 3456
#define XB_SPIN_CAP (1u << 18)

__device__ __forceinline__ unsigned xb_ld(unsigned* p)              { return __hip_atomic_load(p, __ATOMIC_RELAXED, __HIP_MEMORY_SCOPE_AGENT); }
__device__ __forceinline__ unsigned xb_add(unsigned* p, unsigned v) { return __hip_atomic_fetch_add(p, v, __ATOMIC_RELAXED, __HIP_MEMORY_SCOPE_AGENT); }
__device__ __forceinline__ unsigned xb_xcc_id() { return (unsigned)__builtin_amdgcn_s_getreg((3 << 11) | 20) & 0xFu; }
#define XB_SPIN(cond, bar) do { unsigned _sp = 0; while (cond) { __builtin_amdgcn_s_sleep(1); \
    if ((++_sp & 255u) == 0u) { if (xb_ld(&(bar)[XB_TMO])) break; if (_sp > XB_SPIN_CAP) { atomicAdd(&(bar)[XB_TMO], 1u); break; } } } } while (0)

struct XcdBarrier {
    unsigned* bar; unsigned x;
    volatile LAS unsigned* st;
};

__device__ __forceinline__ XcdBarrier xcd_barrier_post(unsigned* bar, volatile LAS unsigned* st, const int tid_x) {
    XcdBarrier b; b.bar = bar; b.x = xb_xcc_id(); b.st = st;
    if (tid_x == 0) (void)xb_add(&bar[XB_XCNT(b.x)], 1u);
    return b;
}
__device__ __forceinline__ void xcd_barrier_complete(unsigned* bar, unsigned x, unsigned& nloc, unsigned& nx) {
    const unsigned G = gridDim.x * gridDim.y * gridDim.z;
    unsigned sum, cnt, mine, sp = 0u;
    for (;;) {
        sum = 0u; cnt = 0u; mine = 0u;
#pragma unroll
        for (unsigned j = 0; j < 16; ++j) { const unsigned c = xb_ld(&bar[XB_XCNT(j)]); sum += c; cnt += (c > 0u) ? 1u : 0u; mine = (j == x) ? c : mine; }
        if (sum == G) break;
        __builtin_amdgcn_s_sleep(1);
        if ((++sp & 255u) == 0u) { if (xb_ld(&bar[XB_TMO])) break; if (sp > XB_SPIN_CAP) { atomicAdd(&bar[XB_TMO], 1u); break; } }
    }
    nloc = mine > 0u ? mine : 1u; nx = cnt > 0u ? cnt : 1u;
}

__device__ __forceinline__ void xcd_barrier(const XcdBarrier& b, const int tid_x) {
    asm volatile("s_waitcnt vmcnt(0)" ::: "memory");
    __syncthreads();
    if (tid_x == 0) {
        unsigned* bar = b.bar;
        __builtin_amdgcn_s_waitcnt(0);
        unsigned nloc = b.st[0], nx = b.st[1];
        if (nloc == 0u) { xcd_barrier_complete(bar, b.x, nloc, nx); b.st[0] = nloc; b.st[1] = nx; }
        const unsigned old = xb_add(&bar[XB_XSUB(b.x)], 1u);
        const unsigned gen = old / nloc;
        if (old + 1u == (gen + 1u) * nloc) {
            __builtin_amdgcn_fence(__ATOMIC_RELEASE, "agent");
            asm volatile("s_waitcnt vmcnt(0)" ::: "memory");
            const unsigned og = xb_add(&bar[XB_TOP], 1u);
            const unsigned tg = og / nx;
            if (og + 1u == (tg + 1u) * nx) xb_add(&bar[XB_TOPGEN], 1u);
            else XB_SPIN(xb_ld(&bar[XB_TOPGEN]) == tg, bar);
            __builtin_amdgcn_fence(__ATOMIC_ACQUIRE, "agent");
            xb_add(&bar[XB_XGEN(b.x)], 1u);
            asm volatile("s_waitcnt vmcnt(0)" ::: "memory");
        } else {
            XB_SPIN(xb_ld(&bar[XB_XGEN(b.x)]) == gen, bar);
            __builtin_amdgcn_fence(__ATOMIC_ACQUIRE, "agent");
            asm volatile("s_waitcnt vmcnt(0)" ::: "memory");
        }
    }
    __syncthreads();
}


__device__ __forceinline__ void tr_load(const float* W, int ld, int k0, int n0, LAS float* scr, int lane) {
    if ((ld & 3) == 0) {
        const int r = lane >> 3, c4 = lane & 7;
        f32x4 v[8];
#pragma unroll
        for (int i = 0; i < 8; ++i) v[i] = *(const f32x4*)(W + (size_t)(k0 + 8 * i + r) * ld + n0 + 4 * c4);
#pragma unroll
        for (int i = 0; i < 8; ++i) { LAS float* d = scr + (4 * c4) * 68 + 8 * i + r; d[0] = v[i].x; d[68] = v[i].y; d[136] = v[i].z; d[204] = v[i].w; }
    } else {
#pragma unroll 8
        for (int i = 0; i < 32; ++i) { const int kk = 2 * i + (lane >> 5); scr[(lane & 31) * 68 + kk] = W[(size_t)(k0 + kk) * ld + n0 + (lane & 31)]; }
    }
    LDS_WAIT(); asm volatile("" ::: "memory");
}
__device__ __forceinline__ void tr_item(const float* W, int ld, int k0, int n0, bf16* WT, int Kd, int drow0, LAS float* scr, int lane) {
    tr_load(W, ld, k0, n0, scr, lane);
    const int c = lane & 7;
#pragma unroll
    for (int j = 0; j < 4; ++j) { const int n = (lane >> 3) + 8 * j; const LAS f32x4* s = (const LAS f32x4*)(scr + n * 68 + 8 * c); const f32x4 a = s[0], b = s[1];
        v4u o; o.x = pk2(a.x, a.y); o.y = pk2(a.z, a.w); o.z = pk2(b.x, b.y); o.w = pk2(b.z, b.w);
        *(v4u*)(WT + (size_t)(drow0 + n) * Kd + k0 + 8 * c) = o; }
    LDS_WAIT(); asm volatile("" ::: "memory");
}
__device__ __forceinline__ void tr_item8(const float* W, int ld, int k0, int n0, unsigned char* WT, int Kd, int drow0, float scale, LAS float* scr, int lane) {
    tr_load(W, ld, k0, n0, scr, lane);
    const int c = lane & 3;
#pragma unroll
    for (int j = 0; j < 2; ++j) { const int n = (lane >> 2) + 16 * j; const LAS f32x4* s = (const LAS f32x4*)(scr + n * 68 + 16 * c); const f32x4 a = s[0] * scale, b = s[1] * scale, cc = s[2] * scale, d = s[3] * scale;
        v4u o; o.x = pg8::cvt_fp8x4(a.x, a.y, a.z, a.w); o.y = pg8::cvt_fp8x4(b.x, b.y, b.z, b.w); o.z = pg8::cvt_fp8x4(cc.x, cc.y, cc.z, cc.w); o.w = pg8::cvt_fp8x4(d.x, d.y, d.z, d.w);
        *(v4u*)(WT + (size_t)(drow0 + n) * Kd + k0 + 16 * c) = o; }
    LDS_WAIT(); asm volatile("" ::: "memory");
}
constexpr float WSCALE8 = 256.f; constexpr int WSCALE8_EXP = 8; constexpr float HSCALE8 = 8.f; constexpr int HSCALE8_EXP = 3; constexpr float YSCALE8 = 16.f;
struct In { const float* p[21]; };
constexpr int I_WIN = 16 * 96, I_WO = 16 * 32, I_W1 = 16 * 112, I_W2 = 56 * 32, I_FFN = 2 * I_W1 + I_W2, I_L0 = I_WIN + I_WO + I_FFN, I_L1A = I_WIN + I_WO, I_TOTAL = I_L0 + I_L1A + NEXP * I_FFN;
__device__ __forceinline__ void tr_ffn_item(int r, const float* w1, const float* w3, const float* w2, bf16* W13, bf16* W2T, LAS float* scr, int lane) {
    if (r < 2 * I_W1) { const bool up = r >= I_W1; if (up) r -= I_W1; const int kb = r / 112, nb = r % 112, n0 = 32 * nb;
        tr_item(up ? w3 : w1, FF, 64 * kb, n0, W13, D, 256 * (n0 >> 7) + (up ? 128 : 0) + (n0 & 127), scr, lane); }
    else { r -= 2 * I_W1; const int kb = r / 32, nb = r % 32; tr_item(w2, D, 64 * kb, 32 * nb, W2T, FF, 32 * nb, scr, lane); }
}
__device__ __forceinline__ void tr_ffn_item8(int r, const float* w1, const float* w3, const float* w2, unsigned char* W13, unsigned char* W2T, LAS float* scr, int lane) {
    if (r < 2 * I_W1) { const bool up = r >= I_W1; if (up) r -= I_W1; const int kb = r / 112, nb = r % 112, n0 = 32 * nb;
        tr_item8(up ? w3 : w1, FF, 64 * kb, n0, W13, D, 256 * (n0 >> 7) + (up ? 128 : 0) + (n0 & 127), WSCALE8, scr, lane); }
    else { r -= 2 * I_W1; const int kb = r / 32, nb = r % 32; tr_item8(w2, D, 64 * kb, 32 * nb, W2T, FF, 32 * nb, WSCALE8, scr, lane); }
}
__device__ __forceinline__ void tr_win_item(const float* w_in, int r, unsigned char* dst, LAS float* scr, int lane) {
    const int k0 = 64 * (r / 96), n0 = 32 * (r % 96);
    tr_item(w_in, WIN_LD, k0, n0, (bf16*)dst, D, n0, scr, lane);
}
__device__ __forceinline__ void transpose_all(const In& in, unsigned char* ws, LAS float* scr, int gw, int NGW, int lane) {
    for (int it = gw; it < I_TOTAL; it += NGW) {
        int r = it;
        if (r < I_L0) {
            if (r < I_WIN) { tr_win_item(in.p[2], r, ws + WS_WIN0, scr, lane); continue; } r -= I_WIN;
            if (r < I_WO) { tr_item(in.p[5], D, 64 * (r / 32), 32 * (r % 32), (bf16*)(ws + WS_WOUT0), D, 32 * (r % 32), scr, lane); continue; } r -= I_WO;
            if (DENSE_FP8) tr_ffn_item8(r, in.p[7], in.p[8], in.p[9], ws + WS_W13_0, ws + WS_W2_0, scr, lane);
            else tr_ffn_item(r, in.p[7], in.p[8], in.p[9], (bf16*)(ws + WS_W13_0), (bf16*)(ws + WS_W2_0), scr, lane);
            continue; }
        r -= I_L0;
        if (r < I_WIN) { tr_win_item(in.p[11], r, ws + WS_WIN1, scr, lane); continue; } r -= I_WIN;
        if (r < I_WO) { tr_item(in.p[14], D, 64 * (r / 32), 32 * (r % 32), (bf16*)(ws + WS_WOUT1), D, 32 * (r % 32), scr, lane); continue; } r -= I_WO;
        const int e = r / I_FFN; r -= e * I_FFN;
        tr_ffn_item8(r, in.p[17] + (size_t)e * D * FF, in.p[18] + (size_t)e * D * FF, in.p[19] + (size_t)e * FF * D, ws + WS_W13E + (size_t)e * 2 * FF * D, ws + WS_W2E + (size_t)e * D * FF, scr, lane);
    }
}

template <int MODE, bool OUT8, bool INB16>
__device__ __forceinline__ void norm_phase(const void* X, const float* gain, void* HBv, const float* wx, int wx_ld, int wx_c0, const float* bfp, float* LF,
                                           int* TOKE, float* TOKG, int* HIST, LAS unsigned char* lds, int tid, int lane, int wave) {
    constexpr int NX = MODE == 1 ? 5 : (MODE == 2 ? 8 : 0);
#define NP_COL(jj, cc) (INB16 ? (16 * lane + 4 * (jj) + (cc)) : (256 * (jj) + 4 * lane + (cc)))
    f32x4 g[4];
#pragma unroll
    for (int j = 0; j < 4; ++j) g[j] = *(const f32x4*)(gain + NP_COL(j, 0));
    f32x4 gw[NX > 0 ? NX : 1][4];
#pragma unroll
    for (int e = 0; e < NX; ++e)
#pragma unroll
        for (int j = 0; j < 4; ++j)
#pragma unroll
            for (int c = 0; c < 4; ++c) gw[e][j][c] = g[j][c] * wx[(size_t)NP_COL(j, c) * wx_ld + wx_c0 + e];
    float bias_l = 0.f; if (MODE == 1) { const int e = (lane >> 3) & 7; bias_l = bfp[e < 5 ? e : 0]; }
    LAS int* lh = (LAS int*)(lds + LDSX_OFF);
    for (int rbk = blockIdx.x; rbk < NRB; rbk += gridDim.x) {
        if (MODE == 2) { if (tid < 8) lh[tid] = 0; __syncthreads(); }
        for (int i = 0; i < 32; ++i) {
            const int row = rbk * 256 + wave * 32 + i;
            f32x4 v[4]; float ss = 0.f;
            if constexpr (INB16) { const v4u* xr = (const v4u*)((const bf16*)X + (size_t)row * D + 16 * lane); const v4u w0 = xr[0], w1 = xr[1];
                v[0] = (f32x4){bf_lo(w0.x), bf_hi(w0.x), bf_lo(w0.y), bf_hi(w0.y)}; v[1] = (f32x4){bf_lo(w0.z), bf_hi(w0.z), bf_lo(w0.w), bf_hi(w0.w)};
                v[2] = (f32x4){bf_lo(w1.x), bf_hi(w1.x), bf_lo(w1.y), bf_hi(w1.y)}; v[3] = (f32x4){bf_lo(w1.z), bf_hi(w1.z), bf_lo(w1.w), bf_hi(w1.w)}; }
            else { const f32x4* xr = (const f32x4*)((const float*)X + (size_t)row * D) + lane;
#pragma unroll
                for (int j = 0; j < 4; ++j) v[j] = xr[64 * j]; }
#pragma unroll
            for (int j = 0; j < 4; ++j) ss += (v[j].x * v[j].x + v[j].y * v[j].y) + (v[j].z * v[j].z + v[j].w * v[j].w);
            const float rstd = 1.0f / sqrtf(wave_sum(ss) * (1.f / D) + EPS);
            f32x4 h[4];
#pragma unroll
            for (int j = 0; j < 4; ++j) h[j] = v[j] * rstd * g[j];
            if constexpr (INB16) {
                if (OUT8) { v4u o; o.x = pg8::cvt_fp8x4(h[0].x, h[0].y, h[0].z, h[0].w); o.y = pg8::cvt_fp8x4(h[1].x, h[1].y, h[1].z, h[1].w); o.z = pg8::cvt_fp8x4(h[2].x, h[2].y, h[2].z, h[2].w); o.w = pg8::cvt_fp8x4(h[3].x, h[3].y, h[3].z, h[3].w);
                    *(v4u*)((unsigned char*)HBv + (size_t)row * D + 16 * lane) = o; }
                else { v4u o0, o1; o0.x = pk2(h[0].x, h[0].y); o0.y = pk2(h[0].z, h[0].w); o0.z = pk2(h[1].x, h[1].y); o0.w = pk2(h[1].z, h[1].w); o1.x = pk2(h[2].x, h[2].y); o1.y = pk2(h[2].z, h[2].w); o1.z = pk2(h[3].x, h[3].y); o1.w = pk2(h[3].z, h[3].w);
                    v4u* d = (v4u*)((bf16*)HBv + (size_t)row * D + 16 * lane); d[0] = o0; d[1] = o1; }
            } else {
#pragma unroll
                for (int j = 0; j < 4; ++j) {
                    if (OUT8) ((unsigned*)((unsigned char*)HBv + (size_t)row * D))[64 * j + lane] = pg8::cvt_fp8x4(h[j].x, h[j].y, h[j].z, h[j].w);
                    else ((unsigned long long*)((bf16*)HBv + (size_t)row * D))[64 * j + lane] = (unsigned long long)pk2(h[j].x, h[j].y) | ((unsigned long long)pk2(h[j].z, h[j].w) << 32); }
            }
            if (NX > 0) {
                float a8[8];
#pragma unroll
                for (int e = 0; e < 8; ++e) { float a = 0.f;
                    if (e < NX) {
#pragma unroll
                        for (int j = 0; j < 4; ++j) a += (v[j].x * gw[e][j].x + v[j].y * gw[e][j].y) + (v[j].z * gw[e][j].z + v[j].w * gw[e][j].w); }
                    a8[e] = a; }
                float a4[4], a2[2], zl;
                { const bool up = (lane & 32) != 0;
#pragma unroll
                  for (int q = 0; q < 4; ++q) { const float keep = up ? a8[q + 4] : a8[q], send = up ? a8[q] : a8[q + 4]; a4[q] = keep + __shfl_xor(send, 32); } }
                { const bool up = (lane & 16) != 0;
#pragma unroll
                  for (int q = 0; q < 2; ++q) { const float keep = up ? a4[q + 2] : a4[q], send = up ? a4[q] : a4[q + 2]; a2[q] = keep + __shfl_xor(send, 16); } }
                { const bool up = (lane & 8) != 0; const float keep = up ? a2[1] : a2[0], send = up ? a2[0] : a2[1]; zl = keep + __shfl_xor(send, 8); }
                zl += __shfl_xor(zl, 4); zl += __shfl_xor(zl, 2); zl += __shfl_xor(zl, 1);
                zl *= rstd;
                if (MODE == 1) {
                    const int b = row >> 11, s = row & 2047, e = (lane >> 3) & 7;
                    const float zz = zl + bias_l; const float ls = fminf(zz, 0.f) - log1pf(expf(-fabsf(zz)));
                    if ((lane & 7) == 0 && e < 5) LF[(size_t)(b * 5 + e) * SEQ + s] = ls;
                } else if (MODE == 2) {
                    float z[8];
#pragma unroll
                    for (int e = 0; e < 8; ++e) z[e] = __uint_as_float(__builtin_amdgcn_readlane(__float_as_uint(zl), 8 * e));
                    int e1 = 0; float v1 = z[0];
#pragma unroll
                    for (int e = 1; e < NX; ++e) if (z[e] > v1) { v1 = z[e]; e1 = e; }
                    int e2 = -1; float v2 = -INFINITY;
#pragma unroll
                    for (int e = 0; e < NX; ++e) if (e != e1 && z[e] > v2) { v2 = z[e]; e2 = e; }
                    const float g1 = 1.f / (1.f + expf(v2 - v1)), g2 = 1.f - g1;
                    if (lane == 0) { TOKE[row] = e1 | (e2 << 8); TOKG[2 * row] = g1; TOKG[2 * row + 1] = g2; __hip_atomic_fetch_add(&lh[e1], 1, __ATOMIC_RELAXED, __HIP_MEMORY_SCOPE_WORKGROUP); __hip_atomic_fetch_add(&lh[e2], 1, __ATOMIC_RELAXED, __HIP_MEMORY_SCOPE_WORKGROUP); }
                }
            }
        }
        if (MODE == 2) { __syncthreads(); if (tid < 8) HIST[rbk * 8 + tid] = lh[tid]; __syncthreads(); }
    }
#undef NP_COL
}

__device__ __forceinline__ unsigned f2bf_bits(float f) { return pk2(f, 0.f) & 0xffffu; }
__device__ __forceinline__ void preattn_phase(const float* LF, v4u* KAUG, const bf16* Kb, float* KMEAN, int gw, int NGW, int lane) {
    for (int it = gw; it < 160 + 1280; it += NGW) {
        if (it < 160) {
            const float* src = LF + (size_t)it * SEQ + 32 * lane; float v[32];
#pragma unroll
            for (int q = 0; q < 8; ++q) { const f32x4 x = *(const f32x4*)(src + 4 * q); v[4 * q] = x.x; v[4 * q + 1] = x.y; v[4 * q + 2] = x.z; v[4 * q + 3] = x.w; }
#pragma unroll
            for (int q = 1; q < 32; ++q) v[q] += v[q - 1];
            float incl = v[31];
#pragma unroll
            for (int o = 1; o < 64; o <<= 1) { const float t = __shfl_up(incl, o); if (lane >= o) incl += t; }
            const float excl = incl - v[31];
            v4u* dst = KAUG + (size_t)it * SEQ + 32 * lane;
#pragma unroll
            for (int q = 0; q < 32; ++q) { const float x = -(excl + v[q]) * 1.4426950408889634f;
                const unsigned h1 = f2bf_bits(x); const float r1 = x - __uint_as_float(h1 << 16);
                const unsigned h2 = f2bf_bits(r1); const float r2 = r1 - __uint_as_float(h2 << 16);
                const unsigned h3 = f2bf_bits(r2);
                v4u o; o.x = h1 | (h2 << 16); o.y = h3; o.z = 0u; o.w = 0u; dst[q] = o; }
        } else {
            const int r = it - 160, n = r & 7, bh = r >> 3, b = bh / 5, h = 5 + bh % 5;
            const bf16* src = Kb + (size_t)(b * SEQ + 256 * n + (lane >> 3)) * D + h * 64 + (lane & 7) * 8;
            float a[8] = {0.f, 0.f, 0.f, 0.f, 0.f, 0.f, 0.f, 0.f};
#pragma unroll 8
            for (int q = 0; q < 32; ++q) { const v4u w = *(const v4u*)(src + (size_t)q * 8 * D);
                a[0] += bf_lo(w.x); a[1] += bf_hi(w.x); a[2] += bf_lo(w.y); a[3] += bf_hi(w.y); a[4] += bf_lo(w.z); a[5] += bf_hi(w.z); a[6] += bf_lo(w.w); a[7] += bf_hi(w.w); }
#pragma unroll
            for (int j = 0; j < 8; ++j) { a[j] += __shfl_xor(a[j], 8); a[j] += __shfl_xor(a[j], 16); a[j] += __shfl_xor(a[j], 32); }
            if (lane < 8) { float* dst = KMEAN + (size_t)r * 64 + lane * 8;
                *(f32x4*)dst = (f32x4){a[0], a[1], a[2], a[3]} * (1.f / 256.f); *(f32x4*)(dst + 4) = (f32x4){a[4], a[5], a[6], a[7]} * (1.f / 256.f); }
        }
    }
}

constexpr int NU_AB = 2 * 160 * 8, NU_C = 192 * 24, NU_ATT = NU_AB + NU_C, NPAIR = 2 * 160 * 4;
__device__ __forceinline__ void attn_phase(const att::Tens& T, LAS unsigned char* lds, int wave, const int do_ab = 1, const int do_c = 1) {
    const int G = gridDim.x, x = blockIdx.x & 7, l = blockIdx.x >> 3, LX = G >> 3;
    if ((G & 7) == 0 && LX >= 4) {
        const int ngrp = LX >> 2, g = l >> 2, m = l & 3;
        if (do_ab && g < ngrp) for (int s = g * 8 + x; s < 320; s += ngrp * 8) { const int ty = s / 160, bh = s % 160, b = bh / 5, h5 = bh % 5;
#pragma unroll 1
            for (int half = 0; half < 2; ++half) { const int qb = half ? m : 7 - m;
                if (ty == 0) att::unit_ring<true>(b, h5, qb, T, (LAS char*)(lds + RING_OFF), wave);
                else att::unit_ring<false>(b, 5 + h5, qb, T, (LAS char*)(lds + RING_OFF), wave); } }
        if (do_c) att::win_units(l, LX, (24 * 24 - l + LX - 1) / LX, x, T, (LAS char*)(lds + RING_OFF), wave);
    } else {
        const int c = blockIdx.x;
        if (do_ab) for (int p = c; p < NPAIR; p += G) { const int pt = p / 320, rem = p % 320, ty = rem / 160, bh = rem % 160, b = bh / 5, h5 = bh % 5;
#pragma unroll 1
            for (int half = 0; half < 2; ++half) { const int qb = half ? pt : 7 - pt;
                if (ty == 0) att::unit_ring<true>(b, h5, qb, T, (LAS char*)(lds + RING_OFF), wave);
                else att::unit_ring<false>(b, 5 + h5, qb, T, (LAS char*)(lds + RING_OFF), wave); } }
        if (do_c) for (int j = c; j < NU_C; j += G) { const int bh = j / 24, k = j % 24, b = bh / 6, h = 10 + bh % 6;
            int type, a0, a1 = 0;
            if (k < 8) { type = att::T_D1; a0 = k; } else if (k < 16) { type = att::T_D4; a0 = (k - 8) >> 2; a1 = (k - 8) & 3; } else { type = att::T_D16; a0 = k - 16; }
            att::unit_win(type, b, h, a0, a1, T, (LAS char*)(lds + RING_OFF), wave); }
    }
}

__device__ __forceinline__ void mixnorm_phase(const bf16* O, const bf16* OX1, const bf16* OX2, const float* LSE, const float* mgain, bf16* Y, int gw, int NGW, int lane) {
    f32x4 g[4];
#pragma unroll
    for (int j = 0; j < 4; ++j) g[j] = *(const f32x4*)(mgain + 16 * lane + 4 * j);
    const int grp = lane < 20 ? 0 : (lane < 40 ? 1 : 2);
    const int lc = grp == 2 ? lane - 40 : 0, hh = lc >> 2;
    struct Raw { v4u w0, w1, a0, a1, b0, b1; float L0, L1, L2; };
    auto load_row = [&](int row, Raw& r) {
        const v4u* src = (const v4u*)(O + (size_t)row * D + 16 * lane); r.w0 = src[0]; r.w1 = src[1];
        const v4u* s1 = (const v4u*)(OX1 + (size_t)row * 384 + 16 * lc); const v4u* s2 = (const v4u*)(OX2 + (size_t)row * 384 + 16 * lc);
        r.a0 = s1[0]; r.a1 = s1[1]; r.b0 = s2[0]; r.b1 = s2[1];
        r.L0 = LSE[(size_t)row * 6 + hh]; r.L1 = LSE[((size_t)NTOK + row) * 6 + hh]; r.L2 = LSE[((size_t)2 * NTOK + row) * 6 + hh]; };
    Raw nx; if (gw < NTOK) load_row(gw, nx);
    for (int row = gw; row < NTOK; row += NGW) {
        const Raw r = nx;
        if (row + NGW < NTOK) load_row(row + NGW, nx);
        float f[16];
        { const v4u w0 = r.w0, w1 = r.w1;
          f[0] = bf_lo(w0.x); f[1] = bf_hi(w0.x); f[2] = bf_lo(w0.y); f[3] = bf_hi(w0.y); f[4] = bf_lo(w0.z); f[5] = bf_hi(w0.z); f[6] = bf_lo(w0.w); f[7] = bf_hi(w0.w);
          f[8] = bf_lo(w1.x); f[9] = bf_hi(w1.x); f[10] = bf_lo(w1.y); f[11] = bf_hi(w1.y); f[12] = bf_lo(w1.z); f[13] = bf_hi(w1.z); f[14] = bf_lo(w1.w); f[15] = bf_hi(w1.w); }
        if (grp == 2) {
            const float mx = fmaxf(r.L0, fmaxf(r.L1, r.L2));
            float w0 = __builtin_amdgcn_exp2f(r.L0 - mx), w1 = __builtin_amdgcn_exp2f(r.L1 - mx), w2 = __builtin_amdgcn_exp2f(r.L2 - mx);
            const float inv = 1.f / (w0 + w1 + w2); w0 *= inv; w1 *= inv; w2 *= inv;
            const v4u a0 = r.a0, a1 = r.a1, b0 = r.b0, b1 = r.b1;
#define MIXC(i, wa, wb, hi_) f[i] = w0 * f[i] + w1 * (hi_ ? bf_hi(wa) : bf_lo(wa)) + w2 * (hi_ ? bf_hi(wb) : bf_lo(wb))
            MIXC(0, a0.x, b0.x, 0); MIXC(1, a0.x, b0.x, 1); MIXC(2, a0.y, b0.y, 0); MIXC(3, a0.y, b0.y, 1); MIXC(4, a0.z, b0.z, 0); MIXC(5, a0.z, b0.z, 1); MIXC(6, a0.w, b0.w, 0); MIXC(7, a0.w, b0.w, 1);
            MIXC(8, a1.x, b1.x, 0); MIXC(9, a1.x, b1.x, 1); MIXC(10, a1.y, b1.y, 0); MIXC(11, a1.y, b1.y, 1); MIXC(12, a1.z, b1.z, 0); MIXC(13, a1.z, b1.z, 1); MIXC(14, a1.w, b1.w, 0); MIXC(15, a1.w, b1.w, 1);
#undef MIXC
        }
        float ss = 0.f;
#pragma unroll
        for (int i = 0; i < 16; ++i) ss += f[i] * f[i];
        const float sT = wave_sum(ss), sA = wave_sum(grp == 0 ? ss : 0.f), sC = wave_sum(grp == 2 ? ss : 0.f), sB = sT - sA - sC;
        const float rs = grp == 0 ? 1.0f / sqrtf(sA * (1.f / 320.f) + EPS) : (grp == 1 ? 1.0f / sqrtf(fmaxf(sB, 0.f) * (1.f / 320.f) + EPS) : 1.0f / sqrtf(sC * (1.f / 384.f) + EPS));
        v4u o0, o1;
        o0.x = pk2(f[0] * rs * g[0].x, f[1] * rs * g[0].y); o0.y = pk2(f[2] * rs * g[0].z, f[3] * rs * g[0].w); o0.z = pk2(f[4] * rs * g[1].x, f[5] * rs * g[1].y); o0.w = pk2(f[6] * rs * g[1].z, f[7] * rs * g[1].w);
        o1.x = pk2(f[8] * rs * g[2].x, f[9] * rs * g[2].y); o1.y = pk2(f[10] * rs * g[2].z, f[11] * rs * g[2].w); o1.z = pk2(f[12] * rs * g[3].x, f[13] * rs * g[3].y); o1.w = pk2(f[14] * rs * g[3].z, f[15] * rs * g[3].w);
        v4u* dst = (v4u*)(Y + (size_t)row * D + 16 * lane); dst[0] = o0; dst[1] = o1;
    }
}

__device__ __forceinline__ void scatter_phase(const int* TOKE, const float* TOKG, const int* HIST, int* TOKS, float* ROWG, int* META, int* BLKE, const bf16* HB, bf16* XG,
                                              LAS unsigned char* lds, int tid, int lane, int wave) {
    LAS int* L = (LAS int*)(lds + LDSX_OFF);
    for (int rbk = blockIdx.x; rbk < NRB; rbk += gridDim.x) {
        if (tid < 32) L[tid] = 0;
        __syncthreads();
        { const int e = tid & 7, part = tid >> 3; int p = 0, tt = 0;
#pragma unroll
          for (int q = 0; q < 4; ++q) { const int r2 = part * 4 + q; const int v = HIST[r2 * 8 + e]; tt += v; if (r2 < rbk) p += v; }
          __hip_atomic_fetch_add(&L[e], p, __ATOMIC_RELAXED, __HIP_MEMORY_SCOPE_WORKGROUP); __hip_atomic_fetch_add(&L[8 + e], tt, __ATOMIC_RELAXED, __HIP_MEMORY_SCOPE_WORKGROUP); }
        __syncthreads();
        if (tid == 0) { int ps = 0;
            for (int e = 0; e < 8; ++e) { L[16 + e] = ps; ps += (L[8 + e] + 255) & ~255; }
            L[24] = ps >> 8; }
        __syncthreads();
        if (wave == 0) {
            int run[8] = {0, 0, 0, 0, 0, 0, 0, 0};
            for (int j = 0; j < 8; ++j) { const int a = 64 * j + lane, t = rbk * 256 + (a >> 1), k = a & 1; const int e = (TOKE[t] >> (8 * k)) & 0xff; int rank = 0;
#pragma unroll
                for (int e2 = 0; e2 < 8; ++e2) { const unsigned long long m = __ballot(e == e2); if (e == e2) rank = run[e2] + __popcll(m & ((1ull << lane) - 1ull)); run[e2] += __popcll(m); }
                const int dest = L[16 + e] + L[e] + rank;
                ROWG[dest] = TOKG[2 * t + k]; TOKS[2 * t + k] = dest; L[32 + a] = dest; }
        }
        __syncthreads();
        for (int i = 0; i < 64; ++i) { const int a = wave * 64 + i, t = rbk * 256 + (a >> 1), dest = L[32 + a];
            const v4u* src = (const v4u*)((const unsigned char*)HB + (size_t)t * D) + lane; v4u* dst = (v4u*)((unsigned char*)XG + (size_t)dest * D) + lane;
            const v4u x0 = src[0]; dst[0] = x0; }
        if (rbk == 0) {
            for (int e = 0; e < 8; ++e) { const int st = L[16 + e], tot = L[8 + e], pad = ((tot + 255) & ~255) - tot;
                for (int i = wave; i < pad; i += NWAVES) { v4u* dst = (v4u*)((unsigned char*)XG + (size_t)(st + tot + i) * D) + lane; const v4u zz = {0u, 0u, 0u, 0u}; dst[0] = zz; if (lane == 0) ROWG[st + tot + i] = 0.f; }
                const int nb = (tot + 255) >> 8; for (int i = tid; i < nb; i += NWAVES * 64) BLKE[(st >> 8) + i] = e; }
            if (tid == 0) META[0] = L[24];
        }
        __syncthreads();
    }
}

__device__ __forceinline__ void final_phase(const bf16* XR, float* out, const unsigned char* Y8, const int* TOKS, const float* gain, int gw, int NGW, int lane) {
    f32x4 g[4];
#pragma unroll
    for (int j = 0; j < 4; ++j) g[j] = *(const f32x4*)(gain + 16 * lane + 4 * j);
    for (int row = gw; row < NTOK; row += NGW) {
        const int s0 = TOKS[2 * row], s1 = TOKS[2 * row + 1];
        const v4u* xr = (const v4u*)(XR + (size_t)row * D + 16 * lane); const v4u w0 = xr[0], w1 = xr[1];
        const v4u ya = *(const v4u*)(Y8 + (size_t)s0 * D + 16 * lane), yb = *(const v4u*)(Y8 + (size_t)s1 * D + 16 * lane);
        f32x4 v[4];
        v[0] = (f32x4){bf_lo(w0.x), bf_hi(w0.x), bf_lo(w0.y), bf_hi(w0.y)}; v[1] = (f32x4){bf_lo(w0.z), bf_hi(w0.z), bf_lo(w0.w), bf_hi(w0.w)};
        v[2] = (f32x4){bf_lo(w1.x), bf_hi(w1.x), bf_lo(w1.y), bf_hi(w1.y)}; v[3] = (f32x4){bf_lo(w1.z), bf_hi(w1.z), bf_lo(w1.w), bf_hi(w1.w)};
        float ss = 0.f;
#pragma unroll
        for (int j = 0; j < 4; ++j) { const unsigned a = ya[j], b = yb[j];
            v[j].x += (__builtin_amdgcn_cvt_f32_fp8(a, 0) + __builtin_amdgcn_cvt_f32_fp8(b, 0)) * (1.f / YSCALE8); v[j].y += (__builtin_amdgcn_cvt_f32_fp8(a, 1) + __builtin_amdgcn_cvt_f32_fp8(b, 1)) * (1.f / YSCALE8);
            v[j].z += (__builtin_amdgcn_cvt_f32_fp8(a, 2) + __builtin_amdgcn_cvt_f32_fp8(b, 2)) * (1.f / YSCALE8); v[j].w += (__builtin_amdgcn_cvt_f32_fp8(a, 3) + __builtin_amdgcn_cvt_f32_fp8(b, 3)) * (1.f / YSCALE8);
            ss += (v[j].x * v[j].x + v[j].y * v[j].y) + (v[j].z * v[j].z + v[j].w * v[j].w); }
        const float rstd = 1.0f / sqrtf(wave_sum(ss) * (1.f / D) + EPS);
        f32x4* o = (f32x4*)(out + (size_t)row * D + 16 * lane);
#pragma unroll
        for (int j = 0; j < 4; ++j) o[j] = v[j] * rstd * g[j];
    }
}

struct Args { In in; float* out; unsigned char* ws; int ph_lo, ph_hi; int probe_rt, pad; };
__global__ void __launch_bounds__(NWAVES * 64, 2) mk_fwd(Args args) {
    extern __shared__ __attribute__((aligned(16))) unsigned char lds_raw[];
    LAS unsigned char* lds = (LAS unsigned char*)lds_raw;
    volatile LAS unsigned* MISC = (volatile LAS unsigned*)(lds + MISC_OFF);
    const int tid0 = threadIdx.x, wave = __builtin_amdgcn_readfirstlane(tid0 >> 6);
    const int G = gridDim.x, gw = blockIdx.x * NWAVES + wave, NGW = G * NWAVES;
    unsigned char* ws = args.ws; const In& in = args.in; float* out = args.out;
    unsigned* ctl = (unsigned*)(ws + WS_CTL);
    for (int u = tid0; u < (LDS_BYTES - LDSCTL_OFF) / 4; u += NWAVES * 64) ((LAS unsigned*)(lds + LDSCTL_OFF))[u] = 0u;
    __syncthreads();
#if MK_ONE_LAUNCH
    XcdBarrier bar = xcd_barrier_post(ctl + CW_BAR, MISC + 8, tid0);
#define GRID_BAR() xcd_barrier(bar, wave * 64 + fresh_lane())
#else
#define GRID_BAR() do {} while (0)
#endif
    const int lo = args.ph_lo, hi = args.ph_hi;
#ifndef PHASE_ON
#define PHASE_ON(k) 1
#endif
#define IN(k) (PHASE_ON(k) && lo <= (k) && (k) < hi)
#ifndef PROBE_PHASE
#define PROBE_PHASE -1
#endif
#ifndef PROBE_RT
#define PROBE_RT 0
#endif
#ifndef PROBE_ATT_MODE
#define PROBE_ATT_MODE 0
#endif
#ifndef PROBE_ATT_AB
#define PROBE_ATT_AB 1
#define PROBE_ATT_C 1
#endif
#define SEAM(k) do { if (IN((k) + 1)) GRID_BAR(); } while (0)
    bf16* HB = (bf16*)(ws + WS_HB); bf16* Qb = (bf16*)(ws + WS_Q); bf16* Kb = (bf16*)(ws + WS_K); bf16* Vb = (bf16*)(ws + WS_V);
    bf16* OX1 = (bf16*)(ws + WS_OX1); bf16* OX2 = (bf16*)(ws + WS_OX2); float* LSE = (float*)(ws + WS_LSE);
    float* LF = (float*)(ws + WS_LF); v4u* KAUG = (v4u*)(ws + WS_KAUG); float* KMEAN = (float*)(ws + WS_KMEAN);
    float* RCOS = (float*)(ws + WS_RCOS); float* RSIN = (float*)(ws + WS_RSIN);
    int* TOKE = (int*)(ws + WS_TOKE); float* TOKG = (float*)(ws + WS_TOKG); int* TOKS = (int*)(ws + WS_TOKS); int* HIST = (int*)(ws + WS_HIST); int* META = (int*)(ws + WS_META); int* BLKE = (int*)(ws + WS_BLKE);
    float* ROWG = (float*)(ws + WS_ROWG); bf16* Hd = (bf16*)(ws + WS_H); bf16* XR = (bf16*)(ws + WS_XR); bf16* XG = (bf16*)(ws + WS_XG); bf16* Yb = (bf16*)(ws + WS_Y); bf16* HCH = (bf16*)(ws + WS_HCH);

#define PHASE(k, ...) if (IN(k)) { { ClkStamp cs_; if ((k) == CLKP) cs_ = clk_begin(); { constexpr int rep_ = 0; (void)rep_; const int lane = fresh_lane(), tid = wave * 64 + lane; (void)tid; __VA_ARGS__ } if ((k) == CLKP) clk_end(cs_); } SEAM(k); if ((k) == PROBE_PHASE) { { constexpr int rep_ = 1; (void)rep_; const int lane = fresh_lane(), tid = wave * 64 + lane; (void)tid; __VA_ARGS__ } SEAM(k); } }
    PHASE(PH_PRO,
        transpose_all(in, ws, (LAS float*)(lds + RING_OFF + wave * 16384), gw, NGW, lane);
        for (int i = blockIdx.x * NWAVES * 64 + tid; i < SEQ * 8; i += G * NWAVES * 64) { const int pos = i >> 3; const int k = i & 7;
            const float inv = exp2f(-(float)k * (18.931568569324174f / 8.f)); const float ang = (float)pos * inv; float rev = ang * 0.15915494309189535f; rev -= floorf(rev);
            RCOS[i] = __builtin_amdgcn_cosf(rev); RSIN[i] = __builtin_amdgcn_sinf(rev); }
        if (blockIdx.x == 0) for (int i = tid; i < D / 2; i += NWAVES * 64) ((unsigned*)(HB + (size_t)NTOK * D))[i] = 0u;
        norm_phase<1, false, false>(in.p[0], in.p[1], HB, in.p[2], WIN_LD, 3 * D, in.p[3], LF, nullptr, nullptr, nullptr, lds, tid, lane, wave);)
#define LAYER_MIX(XIN, XIN32, PQKV, PPRE, PATT, PMIX, PWO, WIN_OFF, WOUT_OFF, MGAIN, AQ) \
    PHASE(PQKV, pg8::Gemm g{HB, (const bf16*)(ws + WIN_OFF), NTOK, 3 * D, D}; pg8::StaticOrder S; S.init(NTOK, 3 * D, G, (int)blockIdx.x); \
        pg8::EpiQKV E{Qb, (size_t)(WS_K - WS_Q) / 2, RCOS, RSIN, att::C2, 5, 0, rep_ ? args.probe_rt : 0}; \
        stagger(STG_QKV); pg8::gemm_phase<pg8::EpiQKV, pg8::StaticOrder, PG8_ALIGN, PG8_SP2>(lds + RING_OFF, g, S, E, wave);) \
    PHASE(PPRE, preattn_phase(LF, KAUG, Kb, KMEAN, gw, NGW, lane);) \
    PHASE(PATT, const att::Tens T{Qb, Kb, Vb, HB, OX1, OX2, LSE, (const att::u32x4*)KAUG, KMEAN, rep_ ? args.probe_rt : 0}; attn_phase(T, lds, wave, rep_ ? PROBE_ATT_AB : 1, rep_ ? PROBE_ATT_C : 1);) \
    PHASE(PMIX, mixnorm_phase(HB, OX1, OX2, LSE, MGAIN, Qb, gw, NGW, lane);) \
    PHASE(PWO, pg8::Gemm g{Qb, (const bf16*)(ws + WOUT_OFF), NTOK, D, D}; pg8::StaticOrder S; S.init(NTOK, D, G, (int)blockIdx.x); \
        pg8::EpiRes<XIN32> E{XIN, XR, D}; \
        stagger(STG_WO); pg8::gemm_phase<pg8::EpiRes<XIN32>, pg8::StaticOrder, PG8_ALIGN, PG8_SP2>(lds + RING_OFF, g, S, E, wave);)

    LAYER_MIX(in.p[0], true, PH_QKV0, PH_PRE0, PH_ATT0, PH_MIX0, PH_WO0, WS_WIN0, WS_WOUT0, in.p[4], CW_AQ0)
#if DENSE_FP8
    PHASE(PH_N2_0, norm_phase<0, true, true>(XR, in.p[6], HB, nullptr, 0, 0, nullptr, nullptr, nullptr, nullptr, nullptr, lds, tid, lane, wave);)
    PHASE(PH_UP0, pg8::Gemm g{HB, (const bf16*)(ws + WS_W13_0), NTOK, 2 * FF, D / 2}; pg8::StaticOrder S; S.init(NTOK, 2 * FF, G, (int)blockIdx.x);
        pg8::EpiSwiglu<true> E{Hd, FF, HSCALE8, rep_ ? args.probe_rt : 0};
        stagger(STG_UP); pg8::gemm_phase<pg8::EpiSwiglu<true>, pg8::StaticOrder, PG8_ALIGN, PG8_SP2, true>(lds + RING_OFF, g, S, E, wave, 127 - WSCALE8_EXP);)
    PHASE(PH_DN0, pg8::Gemm g{Hd, (const bf16*)(ws + WS_W2_0), NTOK, D, FF / 2}; pg8::StaticOrder S; S.init(NTOK, D, G, (int)blockIdx.x);
        pg8::EpiRes<false> E{XR, XR, D};
        stagger(STG_DN); pg8::gemm_phase<pg8::EpiRes<false>, pg8::StaticOrder, PG8_ALIGN, PG8_SP2, true>(lds + RING_OFF, g, S, E, wave, 127 - WSCALE8_EXP - HSCALE8_EXP);)
#else
    PHASE(PH_N2_0, norm_phase<0, false, true>(XR, in.p[6], HB, nullptr, 0, 0, nullptr, nullptr, nullptr, nullptr, nullptr, lds, tid, lane, wave);)
    PHASE(PH_UP0, pg8::Gemm g{HB, (const bf16*)(ws + WS_W13_0), NTOK, 2 * FF, D}; pg8::StaticOrder S; S.init(NTOK, 2 * FF, G, (int)blockIdx.x);
        pg8::EpiSwiglu<false> E{Hd, FF, 1.f, 0};
        pg8::gemm_phase<pg8::EpiSwiglu<false>, pg8::StaticOrder, PG8_ALIGN, PG8_SP2>(lds + RING_OFF, g, S, E, wave);)
    PHASE(PH_DN0, pg8::Gemm g{Hd, (const bf16*)(ws + WS_W2_0), NTOK, D, FF}; pg8::StaticOrder S; S.init(NTOK, D, G, (int)blockIdx.x);
        pg8::EpiRes<false> E{XR, XR, D};
        pg8::gemm_phase<pg8::EpiRes<false>, pg8::StaticOrder, PG8_ALIGN, PG8_SP2>(lds + RING_OFF, g, S, E, wave);)
#endif
    PHASE(PH_N1_1, norm_phase<1, false, true>(XR, in.p[10], HB, in.p[11], WIN_LD, 3 * D, in.p[12], LF, nullptr, nullptr, nullptr, lds, tid, lane, wave);)
    LAYER_MIX(XR, false, PH_QKV1, PH_PRE1, PH_ATT1, PH_MIX1, PH_WO1, WS_WIN1, WS_WOUT1, in.p[13], CW_AQ1)
    PHASE(PH_N2_1, norm_phase<2, true, true>(XR, in.p[15], HB, in.p[16], NEXP, 0, nullptr, nullptr, TOKE, TOKG, HIST, lds, tid, lane, wave);)
    PHASE(PH_SCAT, scatter_phase(TOKE, TOKG, HIST, TOKS, ROWG, META, BLKE, HB, XG, lds, tid, lane, wave);)
#pragma unroll 1
    for (int c = 0; c < NCHUNK; ++c) {
        const int pu = PH_MOE0 + 2 * c, pd = pu + 1;
        if (IN(pu) || IN(pd)) {
            const int nblk = __builtin_amdgcn_readfirstlane(META[0]); int nb = nblk - c * CHUNK_BLK; nb = nb < 0 ? 0 : (nb > CHUNK_BLK ? CHUNK_BLK : nb);
            LAS int* be = (LAS int*)(lds + LDSX_OFF);
            __syncthreads();
            for (int i = wave * 64 + fresh_lane(); i < nb; i += NWAVES * 64) be[i] = BLKE[c * CHUNK_BLK + i];
            __syncthreads();
#define MOE_UP { pg8::Gemm g{XG + (size_t)c * CHUNK_BLK * 256 * (D / 2), (const bf16*)(ws + WS_W13E), nb * 256, 2 * FF, D / 2}; \
                pg8::MoeOrder S; S.init(nb * 256, 2 * FF, G, (int)blockIdx.x); S.be_lds = be; S.estride = (size_t)2 * FF * D; \
                pg8::EpiSwiglu<true> E{HCH, FF, HSCALE8, 0}; stagger(STG_MUP); \
                pg8::gemm_phase<pg8::EpiSwiglu<true>, pg8::MoeOrder, PG8_ALIGN, PG8_SP2, true>(lds + RING_OFF, g, S, E, wave, 127 - WSCALE8_EXP); SEAM(pu); }
#define MOE_DN { pg8::Gemm g{HCH, (const bf16*)(ws + WS_W2E), nb * 256, D, FF / 2}; \
                pg8::MoeOrder S; S.init(nb * 256, D, G, (int)blockIdx.x); S.be_lds = be; S.estride = (size_t)D * FF; \
                pg8::EpiY E{(unsigned char*)Yb, ROWG, c * CHUNK_BLK * 256, YSCALE8}; stagger(STG_MDN); \
                pg8::gemm_phase<pg8::EpiY, pg8::MoeOrder, PG8_ALIGN, PG8_SP2, true>(lds + RING_OFF, g, S, E, wave, 127 - WSCALE8_EXP - HSCALE8_EXP); SEAM(pd); }
            if (IN(pu)) { MOE_UP if (PROBE_PHASE == PH_MOE0) MOE_UP }
            if (IN(pd)) { MOE_DN if (PROBE_PHASE == PH_MOE0 + 1) MOE_DN }
        }
    }
    if (IN(PH_FINAL)) final_phase(XR, out, (const unsigned char*)Yb, TOKS, in.p[20], gw, NGW, fresh_lane());
#undef IN
#undef SEAM
}

extern "C" void kernel_launch(void* const* d_in, const int* in_sizes, int n_in, void* d_out, int out_size, void* d_ws, size_t ws_size, hipStream_t stream) {
    static int grid = 0;
    if (grid == 0) {
        if (n_in != 21 || in_sizes[0] != NTOK * D || out_size != NTOK * D || ws_size < WS_END) { fprintf(stderr, "kernel_launch: unexpected shapes (n_in %d, in0 %d, out %d, ws %zu); nothing launched\n", n_in, n_in > 0 ? in_sizes[0] : -1, out_size, ws_size); grid = -1; return; }
        int dev = 0, cus = 0, per_cu = 0;
        if (hipGetDevice(&dev) != hipSuccess || hipDeviceGetAttribute(&cus, hipDeviceAttributeMultiprocessorCount, dev) != hipSuccess) { grid = -1; return; }
        if (hipFuncSetAttribute((const void*)mk_fwd, hipFuncAttributeMaxDynamicSharedMemorySize, LDS_BYTES) != hipSuccess) { fprintf(stderr, "kernel_launch: hipFuncSetAttribute failed\n"); grid = -1; return; }
        if (hipOccupancyMaxActiveBlocksPerMultiprocessor(&per_cu, (const void*)mk_fwd, NWAVES * 64, LDS_BYTES) != hipSuccess || per_cu < 1) { fprintf(stderr, "kernel_launch: occupancy query reports %d blocks per CU\n", per_cu); }
        (void)hipGetLastError();
        grid = cus;
    }
    if (grid < 0) return;
    if (hipMemsetAsync((char*)d_ws + WS_CTL, 0, CTL_ZERO_BYTES, stream) != hipSuccess) return;
    Args a{};
    for (int i = 0; i < 21; ++i) a.in.p[i] = (const float*)d_in[i];
    a.out = (float*)d_out; a.ws = (unsigned char*)d_ws; a.probe_rt = PROBE_RT;
#if MK_ONE_LAUNCH
    a.ph_lo = 0; a.ph_hi = PH_COUNT;
    hipLaunchKernelGGL(mk_fwd, dim3(grid), dim3(NWAVES * 64), LDS_BYTES, stream, a);
#else
    for (int p = 0; p < PH_COUNT; ++p) { a.ph_lo = p; a.ph_hi = p + 1; hipLaunchKernelGGL(mk_fwd, dim3(grid), dim3(NWAVES * 64), LDS_BYTES, stream, a); }
#endif
}
```

```cpp
#include <hip/hip_runtime.h>
#include <hip/hip_bf16.h>
#include <cstdio>
#include <cstdint>
#include <cmath>
__device__ __forceinline__ int fresh_lane() { int l; asm volatile("v_mbcnt_lo_u32_b32 %0, -1, 0\n\tv_mbcnt_hi_u32_b32 %0, -1, %0" : "=v"(l)); return l; }
namespace pg8 {
#define PG8_LAS __attribute__((address_space(3)))
typedef unsigned short bf16_t;
typedef short bf16x8 __attribute__((ext_vector_type(8)));
typedef float f32x4 __attribute__((ext_vector_type(4)));
typedef unsigned u32x4 __attribute__((ext_vector_type(4)));
constexpr int BM = 256, BK = 64, HALF = 128, HTB = HALF * BK * 2  , STAGE_BYTES = 8 * HTB, NXCD = 8, WGM = 8;

__host__ __device__ __forceinline__ int lds_byte(int r, int c) { const int st = (r >> 4) * 2 + (c >> 5), rr = r & 15, cc = c & 31, ob = rr * 64 + cc * 2; return st * 1024 + (ob ^ (((ob >> 9) & 1) << 5)); }
__host__ __device__ __forceinline__ void stage_rc(int b, int& R, int& C) { const int st = b / 1024, sb = b % 1024, swz = sb ^ (((sb >> 9) & 1) << 5); R = (st >> 1) * 16 + swz / 64; C = (st & 1) * 32 + (swz % 64) / 2; }
__host__ __device__ __forceinline__ int perm32(int rho) { const int n = rho >> 4, i = rho & 15; return 8 * (i >> 2) + 4 * n + (i & 3); }

typedef int v8i32 __attribute__((ext_vector_type(8))); typedef int v4i32 __attribute__((ext_vector_type(4)));
__device__ __forceinline__ v8i32 pg8_cat(const bf16x8 lo, const bf16x8 hi) { const v4i32 a = __builtin_bit_cast(v4i32, lo), b = __builtin_bit_cast(v4i32, hi); return __builtin_shufflevector(a, b, 0, 1, 2, 3, 4, 5, 6, 7); }
template <int OFF> __device__ __forceinline__ void pg8_glds16(const char* sbase, unsigned voff, unsigned lds_base) { unsigned keep;
    asm volatile("s_mov_b32 %0, m0\n\ts_add_u32 m0, %3, %4\n\ts_nop 0\n\tglobal_load_lds_dwordx4 %1, %2\n\ts_mov_b32 m0, %0" : "=&s"(keep) : "v"(voff), "s"(sbase), "s"(lds_base), "i"(OFF) : "memory", "scc"); }
#ifndef PG8_SADDR_BF16
#define PG8_SADDR_BF16 true
#endif
struct Unit { int pm, pn; };
struct Gemm { const bf16_t* A; const bf16_t* Bt; int M, N, K; };

struct StaticOrder {
    int nM, nN, nwg, G, c; int rev = 0; int kst = 0;
    __host__ __device__ void init(int M, int N, int G_, int c_) { nM = M / BM; nN = N / BM; nwg = nM * nN; G = G_; c = c_; }
    __host__ __device__ bool next(int i, Unit& u) const {
        const long L = (long)i * G + c; if (L >= nwg) return false;
        int wgid = (int)L; { const int q = nwg / NXCD, r = nwg % NXCD, xcd = wgid % NXCD, off = wgid / NXCD; wgid = (xcd < r ? xcd * (q + 1) : r * (q + 1) + (xcd - r) * q) + off; }
        const int nig = WGM * nN, gid = wgid / nig, fm = gid * WGM, gsz = (nM - fm) < WGM ? (nM - fm) : WGM;
        u.pm = fm + ((wgid % nig) % gsz); u.pn = (wgid % nig) / gsz; if (rev) u.pm = nM - 1 - u.pm; return true;
    }
    __device__ __forceinline__ size_t b_off(const Unit&) const { return 0; }
    __device__ __forceinline__ void a_ready(const Unit&) const {}
    __device__ __forceinline__ void done(const Unit&) const {}
};


typedef float f32x2 __attribute__((ext_vector_type(2)));
#ifndef WT_STORES
#define WT_STORES 0
#endif
__device__ __forceinline__ void st16w(void* p, const u32x4 v) {
    if (WT_STORES) asm volatile("global_store_dwordx4 %0, %1, off sc1\n\ts_nop 1" :: "v"(p), "v"(v) : "memory");
    else *(u32x4*)p = v;
}
__device__ __forceinline__ void st16(void* p, const u32x4 v) { *(u32x4*)p = v; }
typedef __bf16 bf16x2_t __attribute__((ext_vector_type(2)));
__device__ __forceinline__ unsigned cvt_pk_bf16(float lo, float hi) { f32x2 v = {lo, hi}; bf16x2_t b = __builtin_convertvector(v, bf16x2_t); return __builtin_bit_cast(unsigned, b); }
__device__ __forceinline__ u32x4 pack8(const f32x4 v0, const f32x4 v1) { u32x4 w; w.x = cvt_pk_bf16(v0[0], v0[1]); w.y = cvt_pk_bf16(v0[2], v0[3]); w.z = cvt_pk_bf16(v1[0], v1[1]); w.w = cvt_pk_bf16(v1[2], v1[3]); return w; }

__device__ __forceinline__ float clamp448(float x) { return __builtin_fminf(__builtin_fmaxf(x, -448.f), 448.f); }
__device__ __forceinline__ unsigned cvt_fp8x4(float a, float b, float c, float d) { int w = __builtin_amdgcn_cvt_pk_fp8_f32(clamp448(a), clamp448(b), 0, false); w = __builtin_amdgcn_cvt_pk_fp8_f32(clamp448(c), clamp448(d), w, true); return (unsigned)w; }

__device__ __forceinline__ unsigned cvt_fp8x4_nc(float a, float b, float c, float d) { int w = __builtin_amdgcn_cvt_pk_fp8_f32(a, b, 0, false); w = __builtin_amdgcn_cvt_pk_fp8_f32(c, d, w, true); return (unsigned)w; }
__device__ __forceinline__ float amax4(float m, const f32x4 v) { m = __builtin_fmaxf(__builtin_fmaxf(m, __builtin_fabsf(v[0])), __builtin_fabsf(v[1])); return __builtin_fmaxf(__builtin_fmaxf(m, __builtin_fabsf(v[2])), __builtin_fabsf(v[3])); }
struct EpiQKV {
    static constexpr bool PERM = true, AFTER_DRAIN = false, KSEG = false;
    bf16_t* QKV; size_t tstride; float* kmean; const float* rstd; float qscale;
     int rope_h0; int pn_off; int mode;
    __device__ __forceinline__ void operator()(const f32x4 (&acc)[2][2][4][2], const Unit& u, int wr, int wc, int fr, int fq) const {
        const int pnq = u.pn + pn_off, tsel = pnq >> 2, pq = pnq & 3;
        bf16_t* base = QKV + (size_t)tsel * tstride;
        const float sc = tsel == 0 ? qscale : 1.f;
        const int row0 = u.pm * BM + wr * 64 + fr, col0 = pq * BM + wc * 32 + 8 * fq;
        const bool ropew = (tsel < 2) && ((wc & 1) == 0) && (4 * pq + 2 + (wc >> 1) >= rope_h0) && !(mode & 2);
        const float pon = fq < 2 ? 1.f : 0.f;
        constexpr float KF[8] = {1.591549431e-01f, 3.086376340e-02f, 5.985185713e-03f, 1.160663641e-03f, 2.250790790e-04f, 4.364795279e-05f, 8.464330808e-06f, 1.641426263e-06f};
        float kf[4];
#pragma unroll
        for (int j = 0; j < 4; ++j) kf[j] = (fq & 1) ? KF[4 + j] : KF[j];
        const bool km0 = tsel == 1 && (4 * pq + (wc >> 1)) >= 5 && (4 * pq + (wc >> 1)) < 10, km1 = tsel == 1 && (4 * pq + 2 + (wc >> 1)) >= 5 && (4 * pq + 2 + (wc >> 1)) < 10;
        f32x4 ks[2][2] = {{{0.f, 0.f, 0.f, 0.f}, {0.f, 0.f, 0.f, 0.f}}, {{0.f, 0.f, 0.f, 0.f}, {0.f, 0.f, 0.f, 0.f}}};
        float rs[2][4];
#pragma unroll
        for (int ai = 0; ai < 2; ++ai)
#pragma unroll
            for (int m = 0; m < 4; ++m) rs[ai][m] = (rstd ? rstd[row0 + ai * HALF + m * 16] : 1.f) * sc;
        asm volatile("" ::: "memory");
#pragma unroll
        for (int ai = 0; ai < 2; ++ai)
#pragma unroll
            for (int m = 0; m < 4; ++m) {
                const int row = row0 + ai * HALF + m * 16;
                float sn[4], cs[4];
                if (ropew) { const float pf = (float)(row & 2047) * pon;
#pragma unroll
                    for (int j = 0; j < 4; ++j) { const float rev = __builtin_amdgcn_fractf(pf * kf[j]); sn[j] = __builtin_amdgcn_sinf(rev); cs[j] = __builtin_amdgcn_cosf(rev); } }
                bf16_t* rowp = base + (size_t)row * 1024 + col0;
#pragma unroll
                for (int bj = 0; bj < 2; ++bj) {
                    f32x4 v0 = acc[ai][bj][m][0], v1 = acc[ai][bj][m][1];
                    const int head = 4 * pq + 2 * bj + (wc >> 1);
                    if (ropew && head >= rope_h0) {
#pragma unroll
                        for (int j = 0; j < 4; ++j) { const float x0 = v0[j], x1 = v1[j]; v0[j] = x0 * cs[j] - x1 * sn[j]; v1[j] = x1 * cs[j] + x0 * sn[j]; }
                    }
                    v0 = v0 * rs[ai][m]; v1 = v1 * rs[ai][m];
                    ks[bj][0] += v0; ks[bj][1] += v1;
                    if (!(mode & 1)) st16(rowp + bj * HALF, pack8(v0, v1));
                }
            }
        if (km0 || km1) {
#pragma unroll
            for (int bj = 0; bj < 2; ++bj) if (bj == 0 ? km0 : km1) {
                float s8[8];
#pragma unroll
                for (int j = 0; j < 4; ++j) { s8[j] = ks[bj][0][j]; s8[4 + j] = ks[bj][1][j]; }
#pragma unroll
                for (int j = 0; j < 8; ++j) { float t = s8[j]; t += __shfl_xor(t, 1); t += __shfl_xor(t, 2); t += __shfl_xor(t, 4); t += __shfl_xor(t, 8); s8[j] = t * (1.f / 256.f); }
                if (fr == 0 && !(mode & 1)) { const int head = 4 * pq + 2 * bj + (wc >> 1), b = u.pm >> 3, blk = u.pm & 7;
                    float* dst = kmean + ((size_t)((b * 5 + head - 5) * 8 + blk)) * 64 + (wc & 1) * 32 + 8 * fq;
#pragma unroll
                    for (int j = 0; j < 8; ++j) atomicAdd(dst + j, s8[j]); }
            }
        }
    }
};

template <bool BASE32> struct EpiRes {
    static constexpr bool PERM = true, AFTER_DRAIN = false, KSEG = false;
    const void* base; bf16_t* out; int ldc;
    __device__ __forceinline__ void operator()(const f32x4 (&acc)[2][2][4][2], const Unit& u, int wr, int wc, int fr, int fq) const {
        const int row0 = u.pm * BM + wr * 64 + fr, col0 = u.pn * BM + wc * 32 + 8 * fq;
        constexpr int DEPTH = BASE32 ? 3 : 4;
        u32x4 b[DEPTH][BASE32 ? 4 : 2];
#define ER_OFF(g) ((size_t)(row0 + ((g) >> 2) * HALF + ((g) & 3) * 16) * ldc + col0)
#define ER_LOAD(g) do { if constexpr (BASE32) { const u32x4* bp = (const u32x4*)((const float*)base + ER_OFF(g)); b[(g) % DEPTH][0] = bp[0]; b[(g) % DEPTH][1] = bp[1]; b[(g) % DEPTH][2] = bp[HALF / 4]; b[(g) % DEPTH][3] = bp[HALF / 4 + 1]; } \
                        else { const bf16_t* bp = (const bf16_t*)base + ER_OFF(g); b[(g) % DEPTH][0] = *(const u32x4*)bp; b[(g) % DEPTH][1] = *(const u32x4*)(bp + HALF); } } while (0)
#pragma unroll
        for (int g = 0; g < DEPTH; ++g) ER_LOAD(g);
#pragma unroll
        for (int g = 0; g < 8; ++g) { const int ai = g >> 2, m = g & 3; u32x4 w[2];
#pragma unroll
            for (int bj = 0; bj < 2; ++bj) { f32x4 b0, b1;
                if constexpr (BASE32) { b0 = __builtin_bit_cast(f32x4, b[g % DEPTH][2 * bj]); b1 = __builtin_bit_cast(f32x4, b[g % DEPTH][2 * bj + 1]); }
                else { const u32x4 x = b[g % DEPTH][bj];
                    b0 = (f32x4){__uint_as_float(x.x << 16), __uint_as_float(x.x & 0xffff0000u), __uint_as_float(x.y << 16), __uint_as_float(x.y & 0xffff0000u)};
                    b1 = (f32x4){__uint_as_float(x.z << 16), __uint_as_float(x.z & 0xffff0000u), __uint_as_float(x.w << 16), __uint_as_float(x.w & 0xffff0000u)}; }
                w[bj] = pack8(b0 + acc[ai][bj][m][0], b1 + acc[ai][bj][m][1]); }
            asm volatile("" ::: "memory");
            st16(out + ER_OFF(g), w[0]); st16(out + ER_OFF(g) + HALF, w[1]);
            asm volatile("" ::: "memory");
            if (g + DEPTH < 8) ER_LOAD(g + DEPTH);
            asm volatile("" ::: "memory");
        }
#undef ER_LOAD
#undef ER_OFF
    }
};

template <bool STAT> struct EpiResS {
    static constexpr bool PERM = true, AFTER_DRAIN = false, KSEG = true;
    const void* base; bf16_t* out; int ldc; unsigned char* x8; unsigned long long* ss; float xs; const float* rab;
    __device__ __forceinline__ void kseg_load(const Unit& u, int wr, int fr, float (&f1)[8], float (&f2)[8]) const {
        const int row0 = u.pm * BM + wr * 64 + fr;
#pragma unroll
        for (int g = 0; g < 8; ++g) { const f32x2 v = *(const f32x2*)(rab + 2 * (size_t)(row0 + (g >> 2) * HALF + (g & 3) * 16)); f1[g] = v.x; f2[g] = v.y; }
    }
    __device__ __forceinline__ void operator()(const f32x4 (&acc)[2][2][4][2], const Unit& u, int wr, int wc, int fr, int fq) const {
        const int row0 = u.pm * BM + wr * 64 + fr, col0 = u.pn * BM + wc * 32 + 8 * fq;
        constexpr int DEPTH = 4;
        u32x4 b[DEPTH][2];
#define ER_OFF(g) ((size_t)(row0 + ((g) >> 2) * HALF + ((g) & 3) * 16) * ldc + col0)
#define ER_LOAD(g) do { const bf16_t* bp = (const bf16_t*)base + ER_OFF(g); b[(g) % DEPTH][0] = *(const u32x4*)bp; b[(g) % DEPTH][1] = *(const u32x4*)(bp + HALF); } while (0)
#pragma unroll
        for (int g = 0; g < DEPTH; ++g) ER_LOAD(g);
#pragma unroll
        for (int g = 0; g < 8; ++g) { const int ai = g >> 2, m = g & 3; u32x4 w[2]; float sq = 0.f; typedef unsigned u32x2 __attribute__((ext_vector_type(2))); u32x2 q8[2];
#pragma unroll
            for (int bj = 0; bj < 2; ++bj) { const u32x4 x = b[g % DEPTH][bj];
                const f32x4 r0 = (f32x4){__uint_as_float(x.x << 16), __uint_as_float(x.x & 0xffff0000u), __uint_as_float(x.y << 16), __uint_as_float(x.y & 0xffff0000u)} + acc[ai][bj][m][0];
                const f32x4 r1 = (f32x4){__uint_as_float(x.z << 16), __uint_as_float(x.z & 0xffff0000u), __uint_as_float(x.w << 16), __uint_as_float(x.w & 0xffff0000u)} + acc[ai][bj][m][1];
                w[bj] = pack8(r0, r1);
                if constexpr (STAT) { sq += (r0[0] * r0[0] + r0[1] * r0[1]) + (r0[2] * r0[2] + r0[3] * r0[3]) + (r1[0] * r1[0] + r1[1] * r1[1]) + (r1[2] * r1[2] + r1[3] * r1[3]);
                    q8[bj].x = cvt_fp8x4(r0[0] * xs, r0[1] * xs, r0[2] * xs, r0[3] * xs); q8[bj].y = cvt_fp8x4(r1[0] * xs, r1[1] * xs, r1[2] * xs, r1[3] * xs); } }
            asm volatile("" ::: "memory");
            st16(out + ER_OFF(g), w[0]); st16(out + ER_OFF(g) + HALF, w[1]);
            if constexpr (STAT) { unsigned char* p8 = x8 + ER_OFF(g); *(u32x2*)p8 = q8[0]; *(u32x2*)(p8 + HALF) = q8[1];
                sq += __shfl_xor(sq, 16); sq += __shfl_xor(sq, 32);
                if (fq == 0) atomicAdd(ss + (row0 + ai * HALF + m * 16), (unsigned long long)(unsigned)(sq * 256.f + 0.5f)); }
            asm volatile("" ::: "memory");
            if (g + DEPTH < 8) ER_LOAD(g + DEPTH);
            asm volatile("" ::: "memory");
        }
#undef ER_LOAD
#undef ER_OFF
    }
};

template <bool OUT8, bool RS = false> struct EpiSwiglu {
    static constexpr bool PERM = true, AFTER_DRAIN = false, KSEG = false;
    void* H; int ldh; float hscale; int mode; const unsigned long long* ss;
    __device__ __forceinline__ void hid(const f32x4 (&acc)[2][2][4][2], int ai, int m, f32x4 (&hv)[2], const float rs = 1.f) const {
        const float rinv = __builtin_amdgcn_rcpf(hscale);
#pragma unroll
        for (int n = 0; n < 2; ++n) { const f32x4 g4 = acc[ai][0][m][n], u4 = acc[ai][1][m][n];
#pragma unroll
            for (int h = 0; h < 2; ++h) { f32x2 g = {g4[2 * h], g4[2 * h + 1]}, up = {u4[2 * h], u4[2 * h + 1]}; if constexpr (RS) { g = g * rs; up = up * rs; }
                if (mode & 2) { const f32x2 s = (g + up) * hscale; hv[n][2 * h] = s.x; hv[n][2 * h + 1] = s.y; }
                else { const f32x2 t = g * -1.4426950408889634f; f32x2 e2 = {__builtin_amdgcn_exp2f(t.x), __builtin_amdgcn_exp2f(t.y)};
                    const f32x2 d = e2 * rinv + rinv; const f32x2 r = {__builtin_amdgcn_rcpf(d.x), __builtin_amdgcn_rcpf(d.y)};
                    const f32x2 o = (g * up) * r; hv[n][2 * h] = o.x; hv[n][2 * h + 1] = o.y; } } }
    }
    __device__ __forceinline__ void operator()(const f32x4 (&acc)[2][2][4][2], const Unit& u, int wr, int wc, int fr, int fq) const {
        const int row0 = u.pm * BM + wr * 64 + fr, col0 = u.pn * HALF + wc * 32 + 8 * fq;
        if constexpr (OUT8) {
            const int odd = fq & 1;
            float rs[2][4];
#pragma unroll
            for (int ai = 0; ai < 2; ++ai)
#pragma unroll
                for (int m = 0; m < 4; ++m) rs[ai][m] = RS ? __builtin_amdgcn_rsqf((float)ss[row0 + ai * HALF + m * 16] * (1.f / (256.f * 1024.f)) + 1e-6f) : 1.f;
            asm volatile("" ::: "memory");
#pragma unroll
            for (int ai = 0; ai < 2; ++ai)
#pragma unroll
                for (int mp = 0; mp < 2; ++mp) {
                    f32x4 ha[2], hb[2]; hid(acc, ai, 2 * mp, ha, rs[ai][2 * mp]); hid(acc, ai, 2 * mp + 1, hb, rs[ai][2 * mp + 1]);
                    const float mx = amax4(amax4(amax4(amax4(0.f, ha[0]), ha[1]), hb[0]), hb[1]);
                    if (__builtin_expect(__any(!(mx <= 448.f)), 0)) {
#pragma unroll
                        for (int n = 0; n < 2; ++n)
#pragma unroll
                            for (int j = 0; j < 4; ++j) { ha[n][j] = clamp448(ha[n][j]); hb[n][j] = clamp448(hb[n][j]); } }
                    const unsigned a0 = cvt_fp8x4_nc(ha[0][0], ha[0][1], ha[0][2], ha[0][3]), a1 = cvt_fp8x4_nc(ha[1][0], ha[1][1], ha[1][2], ha[1][3]);
                    const unsigned b0 = cvt_fp8x4_nc(hb[0][0], hb[0][1], hb[0][2], hb[0][3]), b1 = cvt_fp8x4_nc(hb[1][0], hb[1][1], hb[1][2], hb[1][3]);
                    const auto r0 = __builtin_amdgcn_permlane16_swap(a0, b0, false, false), r1 = __builtin_amdgcn_permlane16_swap(a1, b1, false, false);
                    u32x4 w; w.x = r0[0]; w.y = r1[0]; w.z = r0[1]; w.w = r1[1];
                    const size_t off = (size_t)(row0 + ai * HALF + (2 * mp + odd) * 16) * ldh + col0 - 8 * odd;
                    if (!(mode & 1)) st16((unsigned char*)H + off, w);
                }
        } else {
#pragma unroll
            for (int ai = 0; ai < 2; ++ai)
#pragma unroll
                for (int m = 0; m < 4; ++m) { f32x4 hv[2]; hid(acc, ai, m, hv);
                    st16((bf16_t*)H + (size_t)(row0 + ai * HALF + m * 16) * ldh + col0, pack8(hv[0], hv[1])); }
        }
    }
};

struct EpiY {
    static constexpr bool PERM = true, AFTER_DRAIN = false, KSEG = false;
    unsigned char* Y; const float* gate; int row_base; float yscale;
    __device__ __forceinline__ void operator()(const f32x4 (&acc)[2][2][4][2], const Unit& u, int wr, int wc, int fr, int fq) const {
        const int row0 = row_base + u.pm * BM + wr * 64 + fr, col0 = u.pn * BM + wc * 32 + 8 * fq, odd = fq & 1;
        float gt[2][4];
#pragma unroll
        for (int ai = 0; ai < 2; ++ai)
#pragma unroll
            for (int m = 0; m < 4; ++m) gt[ai][m] = gate[row0 + ai * HALF + m * 16];
        asm volatile("" ::: "memory");
#pragma unroll
        for (int ai = 0; ai < 2; ++ai)
#pragma unroll
            for (int mp = 0; mp < 2; ++mp) { const int rowA = row0 + ai * HALF + (2 * mp) * 16, rowB = rowA + 16; const float ga = gt[ai][2 * mp] * yscale, gb = gt[ai][2 * mp + 1] * yscale;
                unsigned char* rowp = Y + (size_t)(odd ? rowB : rowA) * 1024 + col0 - 8 * odd;
#pragma unroll
                for (int bj = 0; bj < 2; ++bj) { const f32x4 a0v = acc[ai][bj][2 * mp][0] * ga, a1v = acc[ai][bj][2 * mp][1] * ga, b0v = acc[ai][bj][2 * mp + 1][0] * gb, b1v = acc[ai][bj][2 * mp + 1][1] * gb;
                    const unsigned a0 = cvt_fp8x4(a0v[0], a0v[1], a0v[2], a0v[3]), a1 = cvt_fp8x4(a1v[0], a1v[1], a1v[2], a1v[3]), b0 = cvt_fp8x4(b0v[0], b0v[1], b0v[2], b0v[3]), b1 = cvt_fp8x4(b1v[0], b1v[1], b1v[2], b1v[3]);
                    const auto r0 = __builtin_amdgcn_permlane16_swap(a0, b0, false, false), r1 = __builtin_amdgcn_permlane16_swap(a1, b1, false, false);
                    u32x4 w; w.x = r0[0]; w.y = r1[0]; w.z = r0[1]; w.w = r1[1];
                    st16(rowp + bj * HALF, w); } }
    }
};

struct MoeOrder : StaticOrder {
    const PG8_LAS int* be_lds; size_t estride;
    __device__ __forceinline__ size_t b_off(const Unit& u) const { return (size_t)__builtin_amdgcn_readfirstlane(be_lds[u.pm]) * estride; }
};
template <class Epi, class Sched, bool ALIGN_EPI = false, bool SP2 = false, bool FP8 = false>
__device__ __forceinline__ void gemm_phase(PG8_LAS unsigned char* lds, const Gemm g, const Sched& S, const Epi& E, const int wave_id, const int sexp = 127) {
    const int wid = wave_id, tid = wave_id * 64 + fresh_lane(), lane = tid & 63, wr = wid >> 2, wc = wid & 3, fr = lane & 15, fq = lane >> 4;
    const int K = g.K, nt = K / BK; const int sexp_v = sexp * 0x01010101;
    unsigned voffA[2], voffB[2];
#pragma unroll
    for (int i = 0; i < 2; ++i) { int R, C; stage_rc(tid * 16 + i * 8192, R, C); const int Rb = Epi::PERM ? ((R & ~31) + perm32(R & 31)) : R;
        voffA[i] = (unsigned)(R * K + C) * 2u; voffB[i] = (unsigned)(Rb * K + C) * 2u; }
    const size_t kstep = (size_t)(BK * 2);
    const size_t hstep = (size_t)HALF * K * 2;
    const size_t tstep = 2 * hstep;
    const unsigned lds_wave = (unsigned)__builtin_amdgcn_readfirstlane((unsigned)(uintptr_t)lds + (unsigned)wid * 1024u); const unsigned ldsw = (unsigned)wid * 1024u;
    const int aoff = lds_byte(wr * 64 + fr, fq * 8), boff = lds_byte(wc * 32 + fr, fq * 8);
#define PG8_SA(b, h) (((b) * 2 + (h)) * HTB)
#define PG8_SB(b, h) ((4 + (b) * 2 + (h)) * HTB)
#define PG8_STAGE(bufoff, gbase, voff) do { if constexpr (FP8 || PG8_SADDR_BF16) {     pg8_glds16<(bufoff)>((const char*)(gbase), (voff)[0], lds_wave); pg8_glds16<(bufoff) + 8192>((const char*)(gbase), (voff)[1], lds_wave); } \
        else { _Pragma("unroll") for (int _i = 0; _i < 2; ++_i) __builtin_amdgcn_global_load_lds((const unsigned*)((const char*)(gbase) + (voff)[_i]), (PG8_LAS unsigned*)(lds + (bufoff) + ldsw + _i * 8192), 16, 0, 0); } } while (0)
#define PG8_LDA(dst, b, h) do { if constexpr (FP8) { _Pragma("unroll") for (int m = 0; m < 4; ++m) { const v4i32 lo_ = *(const PG8_LAS v4i32*)(lds + PG8_SA(b, h) + aoff + m * 2048), hi_ = *(const PG8_LAS v4i32*)(lds + PG8_SA(b, h) + aoff + m * 2048 + 1024); dst##8[m] = __builtin_shufflevector(lo_, hi_, 0, 1, 2, 3, 4, 5, 6, 7); } } else { \
        _Pragma("unroll") for (int m = 0; m < 4; ++m) _Pragma("unroll") for (int k = 0; k < 2; ++k) dst[m][k] = *(const PG8_LAS bf16x8*)(lds + PG8_SA(b, h) + aoff + m * 2048 + k * 1024); } } while (0)
#define PG8_LDB(dst, b, h) do { if constexpr (FP8) { _Pragma("unroll") for (int n = 0; n < 2; ++n) { const v4i32 lo_ = *(const PG8_LAS v4i32*)(lds + PG8_SB(b, h) + boff + n * 2048), hi_ = *(const PG8_LAS v4i32*)(lds + PG8_SB(b, h) + boff + n * 2048 + 1024); dst##8[n] = __builtin_shufflevector(lo_, hi_, 0, 1, 2, 3, 4, 5, 6, 7); } } else { \
        _Pragma("unroll") for (int n = 0; n < 2; ++n) _Pragma("unroll") for (int k = 0; k < 2; ++k) dst[n][k] = *(const PG8_LAS bf16x8*)(lds + PG8_SB(b, h) + boff + n * 2048 + k * 1024); } } while (0)
#define PG8_MMA(ai, bj, At, Bt) do { __builtin_amdgcn_s_setprio(1); if constexpr (FP8) { _Pragma("unroll") for (int m = 0; m < 4; ++m) _Pragma("unroll") for (int n = 0; n < 2; ++n) \
        acc[ai][bj][m][n] = __builtin_amdgcn_mfma_scale_f32_16x16x128_f8f6f4(Bt##8[n], At##8[m], acc[ai][bj][m][n], 0, 0, 0, sexp_v, 0, 0x7f7f7f7f); } else { \
        _Pragma("unroll") for (int m = 0; m < 4; ++m) _Pragma("unroll") for (int n = 0; n < 2; ++n) _Pragma("unroll") for (int k = 0; k < 2; ++k) \
        acc[ai][bj][m][n] = __builtin_amdgcn_mfma_f32_16x16x32_bf16(Bt[n][k], At[m][k], acc[ai][bj][m][n], 0, 0, 0); } __builtin_amdgcn_s_setprio(0); } while (0)
#define PG8_WAIT_V(n) asm volatile("s_waitcnt vmcnt(" #n ")" ::: "memory")
#define PG8_WAIT_L(n) asm volatile("s_waitcnt lgkmcnt(" #n ")" ::: "memory")
#define PG8_BAR __builtin_amdgcn_s_barrier()
#define PG8_SCHED __builtin_amdgcn_sched_barrier(0)
    Unit cur, nxt; int ui = 0;
#ifdef KSTAMP
    unsigned long long kst_sum = 0, kst_epi = 0; unsigned kst_n = 0;
#endif
    PG8_LAS int* utab = (PG8_LAS int*)(lds + STAGE_BYTES);
    { const int nr = (S.nwg + S.G - 1) / S.G + 1;
      for (int i = tid; i < nr; i += 512) { Unit uu; const bool ok = S.next(i, uu); utab[2 * i] = ok ? uu.pm : -1; utab[2 * i + 1] = uu.pn; }
      asm volatile("s_waitcnt lgkmcnt(0)" ::: "memory"); __builtin_amdgcn_s_barrier(); }
#define PG8_NEXT(i, u) ([&]() { const int pm_ = __builtin_amdgcn_readfirstlane(utab[2 * (i)]), pn_ = __builtin_amdgcn_readfirstlane(utab[2 * (i) + 1]); (u).pm = pm_; (u).pn = pn_; return pm_ >= 0; }())
    if (!PG8_NEXT(0, cur)) return;
    f32x4 acc[2][2][4][2];
#pragma unroll
    for (int a = 0; a < 2; ++a)
#pragma unroll
        for (int b = 0; b < 2; ++b)
#pragma unroll
            for (int m = 0; m < 4; ++m)
#pragma unroll
                for (int n = 0; n < 2; ++n) acc[a][b][m][n] = (f32x4){0.f, 0.f, 0.f, 0.f};
    float kf1[8], kf2[8];
    bf16x8 At[4][2], B0[2][2], B1[2][2]; v8i32 At8[4], B08[2], B18[2];
    const char* cA = (const char*)g.A + (size_t)cur.pm * tstep; const char* cB = (const char*)g.Bt + S.b_off(cur) + (size_t)cur.pn * tstep;
    S.a_ready(cur);
    if constexpr (SP2) {
        PG8_STAGE(PG8_SB(0, 0), cB, voffB); PG8_STAGE(PG8_SB(0, 1), cB + hstep, voffB); PG8_STAGE(PG8_SA(0, 0), cA, voffA); PG8_STAGE(PG8_SA(0, 1), cA + hstep, voffA);
        if (wr == 1) PG8_BAR;
        PG8_WAIT_V(2); PG8_BAR;
        PG8_STAGE(PG8_SB(1, 0), cB + kstep, voffB); PG8_STAGE(PG8_SA(1, 0), cA + kstep, voffA); PG8_STAGE(PG8_SB(1, 1), cB + hstep + kstep, voffB);
        PG8_WAIT_V(6); PG8_BAR;
    } else {
        PG8_STAGE(PG8_SB(0, 0), cB, voffB); PG8_STAGE(PG8_SA(0, 0), cA, voffA); PG8_STAGE(PG8_SB(0, 1), cB + hstep, voffB); PG8_STAGE(PG8_SA(0, 1), cA + hstep, voffA);
        if (wr == 1) PG8_BAR;
        PG8_WAIT_V(4); PG8_BAR;
        PG8_STAGE(PG8_SB(1, 0), cB + kstep, voffB); PG8_STAGE(PG8_SA(1, 0), cA + kstep, voffA); PG8_STAGE(PG8_SB(1, 1), cB + hstep + kstep, voffB);
        PG8_WAIT_V(6); PG8_BAR;
    }
    for (;;) {
        const bool has_next = PG8_NEXT(ui + 1, nxt);
        if constexpr (Epi::KSEG) { E.kseg_load(cur, wr, fresh_lane() & 15, kf1, kf2); }
        const char* nA = has_next ? (const char*)g.A + (size_t)nxt.pm * tstep : cA; const char* nB = has_next ? (const char*)g.Bt + S.b_off(nxt) + (size_t)nxt.pn * tstep : cB;
#ifdef KSTAMP
        const unsigned long long kst_t0 = __builtin_amdgcn_s_memtime();
#endif
#pragma unroll 1
        for (int t = 0; t < nt; t += 2) {
            const bool last = (t == nt - 2);
            const char* a1 = cA + (size_t)(t + 1) * kstep;
            const char* a2 = last ? nA : cA + (size_t)(t + 2) * kstep; const char* b2 = last ? nB : cB + (size_t)(t + 2) * kstep;
            const char* a3 = a2 + kstep; const char* b3 = b2 + kstep;
            if (last && has_next) S.a_ready(nxt);
            if constexpr (SP2) {
            PG8_LDB(B0, 0, 0); PG8_LDB(B1, 0, 1); PG8_SCHED; PG8_LDA(At, 0, 0); PG8_STAGE(PG8_SA(1, 1), a1 + hstep, voffA);
            PG8_WAIT_V(8); PG8_WAIT_L(0); PG8_BAR; PG8_MMA(0, 0, At, B0); PG8_MMA(0, 1, At, B1); PG8_BAR; PG8_SCHED;
            PG8_LDA(At, 0, 1); PG8_STAGE(PG8_SB(0, 0), b2, voffB); PG8_STAGE(PG8_SB(0, 1), b2 + hstep, voffB); PG8_STAGE(PG8_SA(0, 0), a2, voffA);
            PG8_WAIT_V(8); PG8_WAIT_L(0); PG8_BAR; PG8_MMA(1, 0, At, B0); PG8_MMA(1, 1, At, B1); PG8_BAR; PG8_SCHED;
            PG8_LDB(B0, 1, 0); PG8_LDB(B1, 1, 1); PG8_SCHED; PG8_LDA(At, 1, 0); PG8_STAGE(PG8_SA(0, 1), a2 + hstep, voffA);
            PG8_WAIT_V(8); PG8_WAIT_L(0); PG8_BAR; PG8_MMA(0, 0, At, B0); PG8_MMA(0, 1, At, B1); PG8_BAR; PG8_SCHED;
            PG8_LDA(At, 1, 1); PG8_STAGE(PG8_SB(1, 0), b3, voffB); PG8_STAGE(PG8_SB(1, 1), b3 + hstep, voffB); PG8_STAGE(PG8_SA(1, 0), a3, voffA);
            PG8_WAIT_V(8); PG8_WAIT_L(0); PG8_BAR; PG8_MMA(1, 0, At, B0); PG8_MMA(1, 1, At, B1); PG8_BAR; PG8_SCHED;
            } else {
            PG8_LDB(B0, 0, 0); PG8_SCHED; PG8_LDA(At, 0, 0); PG8_STAGE(PG8_SA(1, 1), a1 + hstep, voffA);
            PG8_WAIT_L(8); PG8_BAR; PG8_WAIT_L(0); PG8_MMA(0, 0, At, B0); PG8_BAR; PG8_SCHED;
            PG8_LDB(B1, 0, 1); PG8_STAGE(PG8_SB(0, 0), b2, voffB);
            PG8_BAR; PG8_WAIT_L(0); PG8_MMA(0, 1, At, B1); PG8_BAR;
            PG8_LDA(At, 0, 1); PG8_STAGE(PG8_SA(0, 0), a2, voffA);
            PG8_BAR; PG8_WAIT_L(0); PG8_MMA(1, 0, At, B0); PG8_BAR; PG8_SCHED;
            PG8_STAGE(PG8_SB(0, 1), b2 + hstep, voffB);
            PG8_WAIT_V(6); PG8_BAR; PG8_MMA(1, 1, At, B1); PG8_BAR;
            PG8_LDB(B0, 1, 0); PG8_SCHED; PG8_LDA(At, 1, 0); PG8_STAGE(PG8_SA(0, 1), a2 + hstep, voffA);
            PG8_WAIT_L(8); PG8_BAR; PG8_WAIT_L(0); PG8_MMA(0, 0, At, B0); PG8_BAR; PG8_SCHED;
            PG8_LDB(B1, 1, 1); PG8_STAGE(PG8_SB(1, 0), b3, voffB);
            PG8_BAR; PG8_WAIT_L(0); PG8_MMA(0, 1, At, B1); PG8_BAR;
            PG8_LDA(At, 1, 1); PG8_STAGE(PG8_SA(1, 0), a3, voffA);
            PG8_BAR; PG8_WAIT_L(0); PG8_MMA(1, 0, At, B0); PG8_BAR; PG8_SCHED;
            PG8_STAGE(PG8_SB(1, 1), b3 + hstep, voffB);
            PG8_WAIT_V(6); PG8_BAR; PG8_MMA(1, 1, At, B1); PG8_BAR;
            }
            if constexpr (Epi::KSEG) { if (t == 4 || t == 10) {
#pragma unroll
                for (int a = 0; a < 2; ++a)
#pragma unroll
                    for (int m = 0; m < 4; ++m) { const float f = t == 4 ? kf1[a * 4 + m] : kf2[a * 4 + m];
#pragma unroll
                        for (int bb = 0; bb < 2; ++bb)
#pragma unroll
                            for (int n = 0; n < 2; ++n) acc[a][bb][m][n] = acc[a][bb][m][n] * f; } } }
        }
#ifdef KSTAMP
        const unsigned long long kst_t1 = __builtin_amdgcn_s_memtime(); kst_sum += kst_t1 - kst_t0; kst_n += (unsigned)nt;
#endif
        if constexpr (ALIGN_EPI) { if (wr == 0) PG8_BAR; }
        if constexpr (!Epi::AFTER_DRAIN) { const int lane_e = fresh_lane();
            E(acc, cur, wr, wc, lane_e & 15, lane_e >> 4); S.done(cur); }
#ifdef KSTAMP
        kst_epi += __builtin_amdgcn_s_memtime() - kst_t1;
#endif
        if (!has_next) break;
#pragma unroll
        for (int a = 0; a < 2; ++a)
#pragma unroll
            for (int b = 0; b < 2; ++b)
#pragma unroll
                for (int m = 0; m < 4; ++m)
#pragma unroll
                    for (int n = 0; n < 2; ++n) acc[a][b][m][n] = (f32x4){0.f, 0.f, 0.f, 0.f};
        cur = nxt; cA = nA; cB = nB; ++ui;
        if constexpr (ALIGN_EPI) { if (wr == 1) PG8_BAR; }
    }
#ifdef KSTAMP
    if (S.kst && (KST_ALL || blockIdx.x == 0)) { const unsigned long long us = S.kst == 1 ? kst_sum / kst_n / 2 : kst_epi / (unsigned)(ui + 1) / 10; const unsigned long long r1 = __builtin_amdgcn_s_memrealtime(); while (__builtin_amdgcn_s_memrealtime() - r1 < us * 100ull) __builtin_amdgcn_s_sleep(8); }
#endif
    PG8_WAIT_V(0);
    if constexpr (!ALIGN_EPI) { if (wr == 0) PG8_BAR; }
    PG8_BAR;
    if constexpr (Epi::AFTER_DRAIN) { E.fused(acc, cur, wr, wc, fr, fq, lds, wid, lane); S.done(cur); }
#undef PG8_NEXT
#undef PG8_SA
#undef PG8_SB
#undef PG8_STAGE
#undef PG8_LDA
#undef PG8_LDB
#undef PG8_MMA
#undef PG8_WAIT_V
#undef PG8_WAIT_L
#undef PG8_BAR
#undef PG8_SCHED
}
}

namespace att {
#define ATT_LAS __attribute__((address_space(3)))
using bf16x8 = __attribute__((ext_vector_type(8))) short;
using s16x4 = __attribute__((ext_vector_type(4))) short;
using f32x16 = __attribute__((ext_vector_type(16))) float;
using u32x4 = __attribute__((ext_vector_type(4))) unsigned;
typedef short v4i16_t __attribute__((ext_vector_type(4)));
typedef unsigned short bf16;
constexpr int SEQ = 2048, PITCH = 1024, NTOK = 32 * 2048;
constexpr int KSLOT = 9216, VSLOT = 8192;
constexpr int NSLOT = 3;
constexpr int L_K = 0, L_V = NSLOT * 2 * KSLOT, L_WS = L_V + NSLOT * 2 * VSLOT, L_OST = 0  , L_BYTES = L_WS + 8 * 256;
constexpr int LD_K = 0, LD_V = 6 * 8192, LD_WS = 12 * 8192, LD_OST = LD_WS + 8 * 256, LD_BYTES = LD_OST + 8 * 4096;
constexpr float C2 = 0.125f * 1.4426950408889634f;
constexpr float THR = 8.f;
enum { T_FOX = 0, T_MOBA = 1, T_D1 = 2, T_D4 = 3, T_D16 = 4 };
struct Tens { const bf16* Q; const bf16* K; const bf16* V; bf16* O; bf16* OX1; bf16* OX2; float* LSE; const u32x4* KAUG; const float* KMEAN; int mode; float* SSQ; };
__device__ __forceinline__ int colofs(int h) { return h < 5 ? 64 * h : (h < 10 ? 64 * h + 64 : (h == 10 ? 320 : (h == 11 ? 704 : 64 * h))); }

__device__ __forceinline__ int crow(int r, int hi) { return (r & 3) + 8 * (r >> 2) + 4 * hi; }
__device__ __forceinline__ void glds16s(const void* sbase, unsigned voff, unsigned lds_dst) { unsigned keep;
    asm volatile("s_mov_b32 %0, m0\n\ts_mov_b32 m0, %3\n\ts_nop 0\n\tglobal_load_lds_dwordx4 %1, %2\n\ts_mov_b32 m0, %0" : "=&s"(keep) : "v"(voff), "s"(sbase), "s"(lds_dst) : "memory"); }
typedef float f32x2_t __attribute__((ext_vector_type(2))); typedef __bf16 bf16x2_t __attribute__((ext_vector_type(2)));
__device__ __forceinline__ unsigned cvtpk_s(float lo, float hi) { f32x2_t v = {lo, hi}; bf16x2_t b = __builtin_convertvector(v, bf16x2_t); return __builtin_bit_cast(unsigned, b); }
__device__ __forceinline__ s16x4 vtr(const ATT_LAS char* p) { return __builtin_bit_cast(s16x4, __builtin_amdgcn_ds_read_tr16_b64_v4i16((ATT_LAS v4i16_t*)p)); }
#define ATT_MX3(a, b, c) __builtin_fmaxf(__builtin_fmaxf((a), (b)), (c))

template <bool AUG> __device__ __forceinline__ void qk_tile(f32x16& p0, f32x16& p1, const ATT_LAS char* kslot, const bf16x8 (&qr)[4], const u32x4 qaug, int r32, int hi) {
    const ATT_LAS char* kp = kslot + hi * 1024 + r32 * 16;
    const bf16x8 qa = __builtin_bit_cast(bf16x8, qaug);
    const f32x16 z = {0.f, 0.f, 0.f, 0.f, 0.f, 0.f, 0.f, 0.f, 0.f, 0.f, 0.f, 0.f, 0.f, 0.f, 0.f, 0.f};
    if (AUG) { const ATT_LAS char* ka = kslot + 8192 + r32 * 16;
        const bf16x8 a0_ = *(const ATT_LAS bf16x8*)(ka), a1_ = *(const ATT_LAS bf16x8*)(ka + 512);
        p0 = __builtin_amdgcn_mfma_f32_32x32x16_bf16(a0_, qa, z, 0, 0, 0); p1 = __builtin_amdgcn_mfma_f32_32x32x16_bf16(a1_, qa, z, 0, 0, 0); }
    else { const u32x4 kcw = {0u, 0x3f800000u, 0x3f803f80u, 0u}; const bf16x8 kc = __builtin_bit_cast(bf16x8, kcw);
        p0 = __builtin_amdgcn_mfma_f32_32x32x16_bf16(kc, qa, z, 0, 0, 0); p1 = __builtin_amdgcn_mfma_f32_32x32x16_bf16(kc, qa, z, 0, 0, 0); }
#pragma unroll
    for (int d0 = 0; d0 < 4; ++d0) {
        const bf16x8 b0 = *(const ATT_LAS bf16x8*)(kp + d0 * 2048), b1 = *(const ATT_LAS bf16x8*)(kp + d0 * 2048 + 512);
        p0 = __builtin_amdgcn_mfma_f32_32x32x16_bf16(b0, qr[d0], p0, 0, 0, 0); p1 = __builtin_amdgcn_mfma_f32_32x32x16_bf16(b1, qr[d0], p1, 0, 0, 0);
    }
}
__device__ __forceinline__ u32x4 qaug_of(float mhat, int hi) {
    const float x = -mhat; const unsigned xb = __float_as_uint(x); const float r1 = x - __uint_as_float(xb & 0xffff0000u); const unsigned rb = __float_as_uint(r1);
    const float r2 = r1 - __uint_as_float(rb & 0xffff0000u); const unsigned sb = __float_as_uint(r2);
    u32x4 q; q.x = 0x3f803f80u; q.y = 0x3f80u | (xb & 0xffff0000u); q.z = (rb >> 16) | (sb & 0xffff0000u); q.w = 0u;
    if (hi) { q.x = 0u; q.y = 0u; q.z = 0u; }
    return q;
}
__device__ __forceinline__ u32x4 qaug_off(u32x4 q, bool on, int hi) { if (!on && hi == 0) q.y = 0xff803f80u; return q; }
__device__ __forceinline__ void exp_pack(f32x16& p0, f32x16& p1, u32x4 (&pw)[4], float& l_reg) {
    float s0 = 0.f, s1 = 0.f;
#pragma unroll
    for (int r = 0; r < 16; ++r) { p0[r] = __builtin_amdgcn_exp2f(p0[r]); p1[r] = __builtin_amdgcn_exp2f(p1[r]); s0 += p0[r]; asm volatile("" : "+v"(s0)); s1 += p1[r]; asm volatile("" : "+v"(s1)); }
    l_reg += s0 + s1;
#pragma unroll
    for (int k = 0; k < 4; ++k) { pw[0][k] = cvtpk_s(p0[2 * k], p0[2 * k + 1]); pw[1][k] = cvtpk_s(p0[8 + 2 * k], p0[9 + 2 * k]); pw[2][k] = cvtpk_s(p1[2 * k], p1[2 * k + 1]); pw[3][k] = cvtpk_s(p1[8 + 2 * k], p1[9 + 2 * k]); }
}
__device__ __forceinline__ void pv_tile(f32x16 (&o)[2], const u32x4 (&pw)[4], const ATT_LAS char* vp) {
#pragma unroll
    for (int d0 = 0; d0 < 2; ++d0)
#pragma unroll
        for (int ks = 0; ks < 4; ++ks) { const s16x4 lo = vtr(vp + d0 * 4096 + ks * 1024), hh = vtr(vp + d0 * 4096 + ks * 1024 + 512);
            const bf16x8 vf = {lo[0], lo[1], lo[2], lo[3], hh[0], hh[1], hh[2], hh[3]};
            o[d0] = __builtin_amdgcn_mfma_f32_32x32x16_bf16(__builtin_bit_cast(bf16x8, pw[ks]), vf, o[d0], 0, 0, 0); }
}
struct St { float mhat, l_reg; f32x16 o[2]; u32x4 qaug; u32x4 pw[4]; const ATT_LAS char* vprev; bool pend; };
__device__ __forceinline__ void st_init(St& s, int hi) { s.mhat = 0.f; s.l_reg = 0.f; s.o[0] = f32x16{}; s.o[1] = f32x16{}; s.qaug = qaug_of(0.f, hi); s.vprev = nullptr; s.pend = false;
#pragma unroll
    for (int k = 0; k < 4; ++k) s.pw[k] = u32x4{0u, 0u, 0u, 0u}; }
template <bool AUG> __device__ __forceinline__ void tile_step(St& s, const ATT_LAS char* kslot, const ATT_LAS char* vslot_l, const bf16x8 (&qr)[4], bool lanesel, bool on, bool hi_act, bool lo_act, int dq,
                                                              ATT_LAS float* wsf, int r32, int hi, const int mode = 0) {
    f32x16 p0, p1;
    if (lanesel) qk_tile<AUG>(p0, p1, kslot, qr, qaug_off(s.qaug, on, hi), r32, hi);
    else qk_tile<AUG>(p0, p1, kslot, qr, s.qaug, r32, hi);
    if (s.pend && !(mode & 16)) pv_tile(s.o, s.pw, s.vprev);
    if (hi_act) {
#pragma unroll
        for (int r = 0; r < 16; ++r) { const int c = (r & 3) + 8 * (r >> 2); if (c > dq) p0[r] = -INFINITY; if (c + 32 > dq) p1[r] = -INFINITY; } }
    if (lo_act) { const int dl_ = dq - 128;
#pragma unroll
        for (int r = 0; r < 16; ++r) { const int c = (r & 3) + 8 * (r >> 2); if (c < dl_) p0[r] = -INFINITY; if (c + 32 < dl_) p1[r] = -INFINITY; } }
    float a = ATT_MX3(p0[0], p0[1], p1[0]), bq = ATT_MX3(p0[2], p0[3], p1[1]); a = ATT_MX3(a, p1[2], p1[3]);
#pragma unroll
    for (int r = 4; r < 16; r += 4) { a = ATT_MX3(a, p0[r], p0[r + 1]); bq = ATT_MX3(bq, p0[r + 2], p0[r + 3]); a = ATT_MX3(a, p1[r], p1[r + 1]); bq = ATT_MX3(bq, p1[r + 2], p1[r + 3]); }
    float rm = (mode & 64) ? 0.f : __builtin_fmaxf(a, bq);
    { auto rr = __builtin_amdgcn_permlane32_swap(__float_as_uint(rm), __float_as_uint(rm), false, false); rm = __builtin_fmaxf(__uint_as_float(rr[0]), __uint_as_float(rr[1])); }
    if (__any(rm > THR)) { const float dl = __builtin_fmaxf(rm, 0.f); s.mhat += dl;
#pragma unroll
        for (int r = 0; r < 16; ++r) { p0[r] -= dl; p1[r] -= dl; }
        s.qaug = qaug_of(s.mhat, hi);
        const float f = __builtin_amdgcn_exp2f(-dl); s.l_reg *= f; if (hi == 0) wsf[r32] = f;
#pragma unroll
        for (int r = 0; r < 16; ++r) { const float fr_ = wsf[crow(r, hi)]; s.o[0][r] *= fr_; s.o[1][r] *= fr_; } }
    if (!(mode & 8)) exp_pack(p0, p1, s.pw, s.l_reg); else { s.l_reg += p0[0] + p1[5]; }
    s.pend = true; s.vprev = vslot_l;
}
template <bool AUG, bool SEL> __device__ __forceinline__ void tile_step_steady(St& s, const ATT_LAS char* kslot, const ATT_LAS char* vslot_l, const bf16x8 (&qr)[4], bool on, ATT_LAS float* wsf, int r32, int hi,
                                                                        const bool hi_act = false, const bool lo_act = false, const int dq = 0) {
    f32x16 p0, p1;
    __builtin_amdgcn_s_setprio(1);
    if (SEL) qk_tile<AUG>(p0, p1, kslot, qr, qaug_off(s.qaug, on, hi), r32, hi);
    else qk_tile<AUG>(p0, p1, kslot, qr, s.qaug, r32, hi);
    __builtin_amdgcn_s_setprio(0);
    if (hi_act) {
#pragma unroll
        for (int r = 0; r < 16; ++r) { const int c = (r & 3) + 8 * (r >> 2); if (c > dq) p0[r] = -INFINITY; if (c + 32 > dq) p1[r] = -INFINITY; } }
    if (lo_act) { const int dl_ = dq - 128;
#pragma unroll
        for (int r = 0; r < 16; ++r) { const int c = (r & 3) + 8 * (r >> 2); if (c < dl_) p0[r] = -INFINITY; if (c + 32 < dl_) p1[r] = -INFINITY; } }
    float a = ATT_MX3(p0[0], p0[1], p1[0]), bq = ATT_MX3(p0[2], p0[3], p1[1]); a = ATT_MX3(a, p1[2], p1[3]);
#pragma unroll
    for (int r = 4; r < 16; r += 4) { a = ATT_MX3(a, p0[r], p0[r + 1]); bq = ATT_MX3(bq, p0[r + 2], p0[r + 3]); a = ATT_MX3(a, p1[r], p1[r + 1]); bq = ATT_MX3(bq, p1[r + 2], p1[r + 3]); }
    float rm = __builtin_fmaxf(a, bq);
    { auto rr = __builtin_amdgcn_permlane32_swap(__float_as_uint(rm), __float_as_uint(rm), false, false); rm = __builtin_fmaxf(__uint_as_float(rr[0]), __uint_as_float(rr[1])); }
    const bool resc = __any(rm > THR);
    if (__builtin_expect(resc, 0)) { const float dl = __builtin_fmaxf(rm, 0.f); s.mhat += dl;
#pragma unroll
        for (int r = 0; r < 16; ++r) { p0[r] -= dl; p1[r] -= dl; }
        s.qaug = qaug_of(s.mhat, hi);
        const float f = __builtin_amdgcn_exp2f(-dl); s.l_reg *= f; if (hi == 0) wsf[r32] = f; }
    const ATT_LAS char* vp = s.vprev;
    s16x4 vlo = vtr(vp), vhi = vtr(vp + 512);
    float s0 = 0.f, s1 = 0.f;
    __builtin_amdgcn_sched_barrier(0);
#pragma unroll
    for (int i = 0; i < 8; ++i) {
        s16x4 nlo = vlo, nhi = vhi;
        if (i < 7) { const int off = ((i + 1) >> 2) * 4096 + ((i + 1) & 3) * 1024; nlo = vtr(vp + off); nhi = vtr(vp + off + 512); }
        const bf16x8 vf = {vlo[0], vlo[1], vlo[2], vlo[3], vhi[0], vhi[1], vhi[2], vhi[3]};
        s.o[i >> 2] = __builtin_amdgcn_mfma_f32_32x32x16_bf16(__builtin_bit_cast(bf16x8, s.pw[i & 3]), vf, s.o[i >> 2], 0, 0, 0);
        if (i < 4) {
#pragma unroll
            for (int j = 0; j < 4; ++j) { p0[4 * i + j] = __builtin_amdgcn_exp2f(p0[4 * i + j]); s0 += p0[4 * i + j]; }
            asm volatile("" : "+v"(s0), "+v"(p0));
        } else {
#pragma unroll
            for (int j = 0; j < 4; ++j) { p1[4 * (i - 4) + j] = __builtin_amdgcn_exp2f(p1[4 * (i - 4) + j]); s1 += p1[4 * (i - 4) + j]; }
            asm volatile("" : "+v"(s1), "+v"(p1));
        }
        __builtin_amdgcn_sched_barrier(0);
        vlo = nlo; vhi = nhi;
    }
#pragma unroll
    for (int r = 0; r < 16; ++r) {   }
    s.l_reg += s0 + s1;
    if (__builtin_expect(resc, 0)) {
#pragma unroll
        for (int r = 0; r < 16; ++r) { const float fr_ = wsf[crow(r, hi)]; s.o[0][r] *= fr_; s.o[1][r] *= fr_; } }
#pragma unroll
    for (int k = 0; k < 4; ++k) { s.pw[0][k] = cvtpk_s(p0[2 * k], p0[2 * k + 1]); s.pw[1][k] = cvtpk_s(p0[8 + 2 * k], p0[9 + 2 * k]); s.pw[2][k] = cvtpk_s(p1[2 * k], p1[2 * k + 1]); s.pw[3][k] = cvtpk_s(p1[8 + 2 * k], p1[9 + 2 * k]); }
    s.vprev = vslot_l;
}
__device__ __forceinline__ void unit_finish(St& s, ATT_LAS float* wsf, ATT_LAS bf16* stg, bf16* Ob, int opitch, int qrow0, int kstr, float* lse_dst, int lane, int r32, int hi, const int mode, float* ssq = nullptr) {
    if (s.pend) pv_tile(s.o, s.pw, s.vprev);
    float l_reg = s.l_reg;
    { auto rr = __builtin_amdgcn_permlane32_swap(__float_as_uint(l_reg), __float_as_uint(l_reg), false, false); l_reg = __uint_as_float(rr[0]) + __uint_as_float(rr[1]); }
    if (hi == 0) wsf[32 + r32] = l_reg;
    if (lse_dst != nullptr && hi == 0 && !(mode & 1)) *lse_dst = s.mhat + __builtin_amdgcn_logf(l_reg);
#pragma unroll
    for (int r = 0; r < 16; ++r) { const int orow = crow(r, hi); const float rl = __builtin_amdgcn_rcpf(wsf[32 + orow]);
        const unsigned w = cvtpk_s(s.o[0][r] * rl, s.o[1][r] * rl);
        stg[orow * 64 + r32] = (bf16)(w & 0xffffu); stg[orow * 64 + 32 + r32] = (bf16)(w >> 16); }
#pragma unroll
    for (int i = 0; i < 4; ++i) { const int row = i * 8 + (lane >> 3), ch = lane & 7; const u32x4 v = *(const ATT_LAS u32x4*)(stg + row * 64 + ch * 8);
        if (!(mode & 1)) pg8::st16w(Ob + (long)(qrow0 + row * kstr) * opitch + ch * 8, v);
        if (ssq != nullptr) {
            float q = 0.f;
#pragma unroll
            for (int k = 0; k < 4; ++k) { const float lo = __uint_as_float(v[k] << 16), hh = __uint_as_float(v[k] & 0xffff0000u); q += lo * lo + hh * hh; }
            q += __shfl_xor(q, 1); q += __shfl_xor(q, 2); q += __shfl_xor(q, 4);
            if (ch == 0) ssq[(long)row * 16] = q; } }
}

template <bool AUG> __device__ __forceinline__ int ring_kidx(int a0, int t) { if (AUG) return 64 * t; return 64 * (t < 4 ? 4 * a0 + t : t - 4); }
template <bool AUG>
__device__ __forceinline__ void unit_ring(const int b, const int h, const int a0, const Tens& T, ATT_LAS char* shm, const int wid) {
    const int lane = fresh_lane(), r32 = lane & 31, hi = lane >> 5;
    const int rb = b * SEQ, NT = 4 * a0 + 4, qmin = 256 * a0 + 32 * wid, qmax = qmin + 31, qrow0 = rb + qmin, qrow = qrow0 + r32;
    const unsigned lds0 = (unsigned)(uintptr_t)shm;
    ATT_LAS float* wsf = (ATT_LAS float*)(shm + L_WS) + wid * 64;
    const bf16* Kh = T.K + (long)rb * PITCH + h * 64; const bf16* Vh = T.V + (long)rb * PITCH + h * 64;
    const unsigned voff_k = (unsigned)(lane * PITCH + wid * 8) * 2u, voff_v = (unsigned)((16 * (wid & 3) + (lane >> 2)) * PITCH + (wid >> 2) * 32 + (lane & 3) * 8) * 2u;
#define ATT_ISSUE1(t_, sub_) do { const int kidx_ = ring_kidx<AUG>(a0, (t_)); \
        if (AUG && wid == 7) glds16s(T.KAUG + ((long)(b * 5 + h) * SEQ + kidx_), (unsigned)lane * 16u, (unsigned)__builtin_amdgcn_readfirstlane(lds0 + L_K + (sub_) * KSLOT + 8192)); \
        glds16s(Kh + (long)kidx_ * PITCH, voff_k, (unsigned)__builtin_amdgcn_readfirstlane(lds0 + L_K + (sub_) * KSLOT + wid * 1024)); \
        glds16s(Vh + (long)kidx_ * PITCH, voff_v, (unsigned)__builtin_amdgcn_readfirstlane(lds0 + L_V + (sub_) * VSLOT + wid * 1024)); } while (0)
#define ATT_ISSUE(pair_, pslot_) do { ATT_ISSUE1(2 * (pair_), 2 * (pslot_)); ATT_ISSUE1(2 * (pair_) + 1, 2 * (pslot_) + 1); } while (0)
    bf16x8 qr[4];
    { const bf16* Qw = T.Q + (long)qrow * PITCH + h * 64 + hi * 8;
#pragma unroll
      for (int d0 = 0; d0 < 4; ++d0) qr[d0] = *reinterpret_cast<const bf16x8*>(Qw + d0 * 16); }
    ATT_ISSUE(0, 0);
    unsigned sel = 0xffu;
    if (!AUG && a0 > 3) {
        float gate[7];
        const float* km = T.KMEAN + (long)((b * 5 + (h - 5)) * 8) * 64 + hi * 8;
#pragma unroll
        for (int n = 0; n < 7; ++n) { float g = 0.f;
            if (n < a0) {
#pragma unroll
                for (int d0 = 0; d0 < 4; ++d0) {
                    const float4 k0 = *(const float4*)(km + n * 64 + d0 * 16), k1 = *(const float4*)(km + n * 64 + d0 * 16 + 4);
                    const bf16x8 qv = qr[d0];
#define ATT_QF(j) __uint_as_float(((unsigned)(unsigned short)qv[j]) << 16)
                    g += ATT_QF(0) * k0.x + ATT_QF(1) * k0.y + ATT_QF(2) * k0.z + ATT_QF(3) * k0.w + ATT_QF(4) * k1.x + ATT_QF(5) * k1.y + ATT_QF(6) * k1.z + ATT_QF(7) * k1.w;
#undef ATT_QF
                }
                g += __shfl_xor(g, 32);
            }
            gate[n] = g; }
        sel = 0u;
#pragma unroll
        for (int k = 0; k < 3; ++k) { float best = -INFINITY; unsigned bi = 0u;
#pragma unroll
            for (int n = 0; n < 7; ++n) { const bool ok = (n < a0) && !((sel >> n) & 1u) && (gate[n] > best); best = ok ? gate[n] : best; bi = ok ? (unsigned)n : bi; }
            sel |= 1u << bi; }
    }
    const ATT_LAS char* shmc = (const ATT_LAS char*)shm;
    const ATT_LAS char* vpl = shmc + L_V + ((lane >> 4) & 1) * 32 + (lane & 3) * 8 + (4 * hi + ((lane & 15) >> 2)) * 64;
    St s; st_init(s, hi); s.vprev = vpl;
    asm volatile("" : "+v"(qr[0]), "+v"(qr[1]), "+v"(qr[2]), "+v"(qr[3]));
    int slot = 0, islot = 1;
    const int ebase = qmin + r32 - 4 * hi, NP = NT / 2;
#define ATT_HEAD asm volatile("s_waitcnt vmcnt(0) lgkmcnt(0)\n\ts_barrier" ::: "memory")
#define ATT_ADV do { islot = (islot + 1 == NSLOT) ? 0 : islot + 1; slot = (slot + 1 == NSLOT) ? 0 : slot + 1; } while (0)
#define ATT_GEN_TILE(t, sub_) do { \
        const int kidx = ring_kidx<AUG>(a0, (t)); \
        const bool past = !AUG && (t) >= 4; \
        const bool need = past || (kidx <= qmax); \
        if (need) { if (past) tile_step_steady<AUG, true>(s, shmc + L_K + (sub_) * KSLOT, vpl + (sub_) * VSLOT, qr, ((sel >> (((t) - 4) >> 2)) & 1u) != 0u, wsf, r32, hi); \
                    else tile_step_steady<AUG, false>(s, shmc + L_K + (sub_) * KSLOT, vpl + (sub_) * VSLOT, qr, true, wsf, r32, hi, kidx + 63 > qmin, false, ebase - kidx); } \
        else { pv_tile(s.o, s.pw, s.vprev); _Pragma("unroll") for (int k_ = 0; k_ < 4; ++k_) s.pw[k_] = u32x4{0u, 0u, 0u, 0u}; }     \
        } while (0)
#define ATT_GEN_PAIR(i) do { ATT_HEAD; if ((i) + 1 < NP) ATT_ISSUE((i) + 1, islot); ATT_GEN_TILE(2 * (i), 2 * slot); ATT_GEN_TILE(2 * (i) + 1, 2 * slot + 1); ATT_ADV; } while (0)
#define ATT_STEADY_PAIR(i, SEL_) do { ATT_HEAD; ATT_ISSUE((i) + 1, islot); \
        tile_step_steady<AUG, SEL_>(s, shmc + L_K + (2 * slot) * KSLOT, vpl + (2 * slot) * VSLOT, qr, SEL_ ? (((sel >> ((2 * (i) - 4) >> 2)) & 1u) != 0u) : true, wsf, r32, hi); \
        tile_step_steady<AUG, SEL_>(s, shmc + L_K + (2 * slot + 1) * KSLOT, vpl + (2 * slot + 1) * VSLOT, qr, SEL_ ? (((sel >> ((2 * (i) + 1 - 4) >> 2)) & 1u) != 0u) : true, wsf, r32, hi); \
        ATT_ADV; } while (0)
    if (AUG) {
        int i = 0;
        if (NP > 2) {
#pragma unroll 1
            for (; i < NP - 2; ++i) ATT_STEADY_PAIR(i, false); }
#pragma unroll 1
        for (; i < NP; ++i) ATT_GEN_PAIR(i);
    } else {
        int i = 0;
#pragma unroll 1
        for (; i < 2; ++i) ATT_GEN_PAIR(i);
        if (NP - 1 > 2) {
#pragma unroll 1
            for (; i < NP - 1; ++i) ATT_STEADY_PAIR(i, true); }
#pragma unroll 1
        for (; i < NP; ++i) ATT_GEN_PAIR(i);
    }
#undef ATT_GEN_TILE
#undef ATT_GEN_PAIR
#undef ATT_STEADY_PAIR
#undef ATT_HEAD
#undef ATT_ADV
    pv_tile(s.o, s.pw, s.vprev); s.pend = false;
    asm volatile("s_waitcnt lgkmcnt(0)\n\ts_barrier" ::: "memory");
    unit_finish(s, wsf, (ATT_LAS bf16*)(shm + L_OST) + wid * 2048, T.O + colofs(h), PITCH, qrow0, 1, nullptr, lane, r32, hi, T.mode, T.SSQ + (long)qrow0 * 16 + h);
    asm volatile("s_waitcnt lgkmcnt(0)\n\ts_barrier" ::: "memory");
#undef ATT_ISSUE
#undef ATT_ISSUE1
}

__device__ __forceinline__ void unit_win(const int type, const int b, const int h, const int a0, const int a1, const Tens& T, ATT_LAS char* shm, const int wid) {
    const int lane = fresh_lane(), r32 = lane & 31, hi = lane >> 5;
    const int rb = b * SEQ;
    int qmin, kstr, rofs, ntl, tw0, ntw;
    if (type == T_D1) { qmin = 256 * a0 + 32 * wid; kstr = 1; rofs = 0; ntl = 6; tw0 = wid >> 1; ntw = 3; }
    else if (type == T_D4) { qmin = 256 * a0 + 32 * wid; kstr = 4; rofs = a1; ntl = 6; tw0 = wid >> 1; ntw = 3; }
    else { qmin = 32 * (wid & 3); kstr = 16; rofs = 2 * a0 + (wid >> 2); ntl = 4; tw0 = 2 * (wid >> 2); ntw = 2; }
    const int qmax = qmin + 31, qrow0 = rb + qmin * kstr + rofs, qrow = qrow0 + r32 * kstr;
    const unsigned lds0 = (unsigned)(uintptr_t)shm;
    ATT_LAS float* wsf = (ATT_LAS float*)(shm + LD_WS) + wid * 64;
    const bf16* Kh = T.K + (long)rb * PITCH + h * 64; const bf16* Vh = T.V + (long)rb * PITCH + h * 64;
    const unsigned voff_k = (unsigned)((lane * kstr) * PITCH + wid * 8) * 2u, voff_v = (unsigned)(((16 * (wid & 3) + (lane >> 2)) * kstr) * PITCH + (wid >> 2) * 32 + (lane & 3) * 8) * 2u;
    bf16x8 qr[4];
    { const bf16* Qw = T.Q + (long)qrow * PITCH + h * 64 + hi * 8;
#pragma unroll
      for (int d0 = 0; d0 < 4; ++d0) qr[d0] = *reinterpret_cast<const bf16x8*>(Qw + d0 * 16); }
    for (int t = 0; t < ntl; ++t) {
        int kidx, row0;
        if (type == T_D16) { kidx = 64 * (t & 1); row0 = 16 * kidx + 2 * a0 + (t >> 1); } else { kidx = 256 * a0 - 128 + 64 * t; row0 = kstr * kidx + rofs; }
        if (kidx >= 0 && !(T.mode & 4)) { glds16s(Kh + (long)row0 * PITCH, voff_k, (unsigned)__builtin_amdgcn_readfirstlane(lds0 + LD_K + t * 8192 + wid * 1024));
                         glds16s(Vh + (long)row0 * PITCH, voff_v, (unsigned)__builtin_amdgcn_readfirstlane(lds0 + LD_V + t * 8192 + wid * 1024)); }
    }
    St s; st_init(s, hi);
    const ATT_LAS char* shmc = (const ATT_LAS char*)shm;
    const ATT_LAS char* vpl = shmc + LD_V + ((lane >> 4) & 1) * 32 + (lane & 3) * 8 + (4 * hi + ((lane & 15) >> 2)) * 64;
    asm volatile("" : "+v"(qr[0]), "+v"(qr[1]), "+v"(qr[2]), "+v"(qr[3]));
    asm volatile("s_waitcnt vmcnt(0) lgkmcnt(0)\n\ts_barrier" ::: "memory");
    const int ebase = qmin + r32 - 4 * hi;
    for (int i = (T.mode & 512) ? ntw : 0; i < ntw; ++i) {
        const int t = tw0 + i;
        const int kidx = (type == T_D16) ? 64 * (t & 1) : 256 * a0 - 128 + 64 * t;
        const bool need = (kidx >= 0) && (kidx <= qmax) && !(T.mode & 2);
        if (need) tile_step<false>(s, shmc + LD_K + t * 8192, vpl + t * 8192, qr, false, true, kidx + 63 > qmin, kidx < qmax - 128, ebase - kidx, wsf, r32, hi, T.mode);
    }
    bf16* Ob; int opitch;
    if (type == T_D1) { Ob = T.O + colofs(h); opitch = PITCH; } else if (type == T_D4) { Ob = T.OX1 + (h - 10) * 64; opitch = 384; } else { Ob = T.OX2 + (h - 10) * 64; opitch = 384; }
    unit_finish(s, wsf, (ATT_LAS bf16*)(shm + LD_OST) + wid * 2048, Ob, opitch, qrow0, kstr, T.LSE + ((long)(type - T_D1) * NTOK + qrow) * 6 + (h - 10), lane, r32, hi, T.mode);
    asm volatile("s_waitcnt lgkmcnt(0)\n\ts_barrier" ::: "memory");
}
struct WinP { int type, b, h, a0, a1; };
__device__ __forceinline__ WinP win_decode(int u, int x) { WinP p; const int bh = (u / 24) * 8 + x, k = u % 24; p.b = bh / 6; p.h = 10 + bh % 6; p.a1 = 0;
    if (k < 8) { p.type = T_D1; p.a0 = k; } else if (k < 16) { p.type = T_D4; p.a0 = (k - 8) >> 2; p.a1 = (k - 8) & 3; } else { p.type = T_D16; p.a0 = k - 16; } return p; }
struct WinW { int qmin, kstr, rofs, ntl, tw0, ntw; };
__device__ __forceinline__ WinW win_wave(const WinP& p, int wid) { WinW w;
    if (p.type == T_D1) { w.qmin = 256 * p.a0 + 32 * wid; w.kstr = 1; w.rofs = 0; w.ntl = 6; w.tw0 = wid >> 1; w.ntw = 3; }
    else if (p.type == T_D4) { w.qmin = 256 * p.a0 + 32 * wid; w.kstr = 4; w.rofs = p.a1; w.ntl = 6; w.tw0 = wid >> 1; w.ntw = 3; }
    else { w.qmin = 32 * (wid & 3); w.kstr = 16; w.rofs = 2 * p.a0 + (wid >> 2); w.ntl = 4; w.tw0 = 2 * (wid >> 2); w.ntw = 2; }
    return w; }
__device__ __forceinline__ void win_request(const WinP& p, const WinW& w, const Tens& T, unsigned lds0, int wid, int lane, int r32, int hi, bf16x8 (&q)[4]) {
    const int rb = p.b * SEQ, qrow = rb + (w.qmin + r32) * w.kstr + w.rofs;
    const bf16* Kh = T.K + (long)rb * PITCH + p.h * 64; const bf16* Vh = T.V + (long)rb * PITCH + p.h * 64;
    const unsigned voff_k = (unsigned)((lane * w.kstr) * PITCH + wid * 8) * 2u, voff_v = (unsigned)(((16 * (wid & 3) + (lane >> 2)) * w.kstr) * PITCH + (wid >> 2) * 32 + (lane & 3) * 8) * 2u;
    { const bf16* Qw = T.Q + (long)qrow * PITCH + p.h * 64 + hi * 8;
#pragma unroll
      for (int d0 = 0; d0 < 4; ++d0) q[d0] = *reinterpret_cast<const bf16x8*>(Qw + d0 * 16); }
    for (int t = 0; t < w.ntl; ++t) {
        int kidx, row0;
        if (p.type == T_D16) { kidx = 64 * (t & 1); row0 = 16 * kidx + 2 * p.a0 + (t >> 1); } else { kidx = 256 * p.a0 - 128 + 64 * t; row0 = w.kstr * kidx + w.rofs; }
        if (kidx >= 0) { glds16s(Kh + (long)row0 * PITCH, voff_k, (unsigned)__builtin_amdgcn_readfirstlane(lds0 + LD_K + t * 8192 + wid * 1024));
                         glds16s(Vh + (long)row0 * PITCH, voff_v, (unsigned)__builtin_amdgcn_readfirstlane(lds0 + LD_V + t * 8192 + wid * 1024)); }
    }
}
__device__ __forceinline__ void win_units(const int u0, const int ustride, const int n, const int x, const Tens& T, ATT_LAS char* shm, const int wid) {
    if (n <= 0) return;
    const int lane = fresh_lane(), r32 = lane & 31, hi = lane >> 5;
    const unsigned lds0 = (unsigned)(uintptr_t)shm;
    ATT_LAS float* wsf = (ATT_LAS float*)(shm + LD_WS) + wid * 64;
    const ATT_LAS char* shmc = (const ATT_LAS char*)shm;
    const ATT_LAS char* vpl = shmc + LD_V + ((lane >> 4) & 1) * 32 + (lane & 3) * 8 + (4 * hi + ((lane & 15) >> 2)) * 64;
    WinP p = win_decode(u0, x); WinW w = win_wave(p, wid);
    bf16x8 qr[4];
    win_request(p, w, T, lds0, wid, lane, r32, hi, qr);
#pragma unroll 1
    for (int idx = 0; idx < n; ++idx) {
        asm volatile("" : "+v"(qr[0]), "+v"(qr[1]), "+v"(qr[2]), "+v"(qr[3]));
        asm volatile("s_waitcnt vmcnt(0) lgkmcnt(0)\n\ts_barrier" ::: "memory");
        St s; st_init(s, hi); s.vprev = vpl + (p.type == T_D16 ? 3 : 5) * 8192;
        const int qmax = w.qmin + 31, ebase = w.qmin + r32 - 4 * hi;
        for (int i = 0; i < w.ntw; ++i) {
            const int t = w.tw0 + i;
            const int kidx = (p.type == T_D16) ? 64 * (t & 1) : 256 * p.a0 - 128 + 64 * t;
            const bool need = (kidx >= 0) && (kidx <= qmax);
            if (need) tile_step_steady<false, false>(s, shmc + LD_K + t * 8192, vpl + t * 8192, qr, true, wsf, r32, hi, kidx + 63 > w.qmin, kidx < qmax - 128, ebase - kidx);
        }
        pv_tile(s.o, s.pw, s.vprev); s.pend = false;
        asm volatile("s_waitcnt lgkmcnt(0)\n\ts_barrier" ::: "memory");
        const WinP pc = p; const WinW wc = w;
        if (idx + 1 < n) { p = win_decode(u0 + (idx + 1) * ustride, x); w = win_wave(p, wid); }
        bf16x8 qn[4] = {qr[0], qr[1], qr[2], qr[3]};
        if (idx + 1 < n) win_request(p, w, T, lds0, wid, lane, r32, hi, qn);
        const int rbc = pc.b * SEQ, qrow0 = rbc + wc.qmin * wc.kstr + wc.rofs, qrow = qrow0 + r32 * wc.kstr;
        bf16* Ob; int opitch;
        if (pc.type == T_D1) { Ob = T.O + colofs(pc.h); opitch = PITCH; } else if (pc.type == T_D4) { Ob = T.OX1 + (pc.h - 10) * 64; opitch = 384; } else { Ob = T.OX2 + (pc.h - 10) * 64; opitch = 384; }
        unit_finish(s, wsf, (ATT_LAS bf16*)(shm + LD_OST) + wid * 2048, Ob, opitch, qrow0, wc.kstr, T.LSE + ((long)(pc.type - T_D1) * NTOK + qrow) * 6 + (pc.h - 10), lane, r32, hi, 0);
#pragma unroll
        for (int d0 = 0; d0 < 4; ++d0) qr[d0] = qn[d0];
    }
    asm volatile("s_waitcnt lgkmcnt(0)\n\ts_barrier" ::: "memory");
}
#undef ATT_MX3
}

constexpr int NWAVES = 8;
#ifndef PG8_ALIGN
#define PG8_ALIGN true
#endif
#ifndef PG8_SP2
#define PG8_SP2 true
#endif
#ifndef DENSE_FP8
#define DENSE_FP8 1
#endif
#ifndef MK_ONE_LAUNCH
#define MK_ONE_LAUNCH 1
#endif
constexpr int BATCH = 32, SEQ = 2048, D = 1024, NTOK = BATCH * SEQ, FF = 3584, NEXP = 8, WIN_LD = 3 * D + 5;
constexpr float EPS = 1e-6f;
constexpr int NRB = NTOK / 256;
constexpr int MAXBLK = 520;
constexpr int CHUNK_BLK = 256, NCHUNK = 2, CHUNK_LAST = MAXBLK - (NCHUNK - 1) * CHUNK_BLK;
enum { PH_PRO = 0, PH_QKV0, PH_PRE0, PH_ATT0, PH_MIX0, PH_WO0, PH_N2_0, PH_UP0, PH_DN0,
       PH_N1_1, PH_QKV1, PH_PRE1, PH_ATT1, PH_MIX1, PH_WO1, PH_N2_1, PH_SCAT, PH_MOE0, PH_FINAL = PH_MOE0 + 2 * NCHUNK, PH_COUNT };
constexpr size_t MiB = 1u << 20;
constexpr size_t WS_CTL = 0, CTL_ZERO_BYTES = 1 * MiB;
constexpr size_t WS_WIN0 = 2 * MiB, WS_WOUT0 = 8 * MiB, WS_W13_0 = 10 * MiB, WS_W2_0 = 24 * MiB;
constexpr size_t WS_WIN1 = 32 * MiB, WS_WOUT1 = 38 * MiB, WS_W13E = 40 * MiB, WS_W2E = 152 * MiB;
constexpr size_t WS_RCOS = 208 * MiB, WS_SS = 208 * MiB  , WS_RSIN = WS_RCOS + 65536, WS_LF = 209 * MiB, WS_RSTD = 209 * MiB + 1280 * 1024  , WS_KMEAN = 210 * MiB + 512 * 1024, WS_KAUG = 211 * MiB;
constexpr size_t WS_TOKE = 216 * MiB, WS_TOKG = WS_TOKE + 256 * 1024, WS_TOKS = WS_TOKG + 512 * 1024, WS_HIST = WS_TOKS + 512 * 1024, WS_META = WS_HIST + 16384, WS_BLKE = WS_META + 4096;
constexpr size_t WS_ROWG = 218 * MiB, WS_LSE = 219 * MiB;
constexpr size_t WS_HB = 224 * MiB;
constexpr size_t WS_Q = 354 * MiB, WS_K = 482 * MiB, WS_V = 610 * MiB, WS_OX1 = 738 * MiB, WS_OX2 = 786 * MiB;
constexpr size_t WS_HB8 = 738 * MiB;
constexpr size_t WS_WV8_OFF = 4 * MiB;
constexpr size_t WS_H = 354 * MiB;
constexpr size_t WS_XG = 354 * MiB, WS_Y = 484 * MiB, WS_HCH = 614 * MiB, WS_XR = 846 * MiB;
constexpr size_t WS_SSQ = 974 * MiB  , WS_RAB = 978 * MiB  ;
constexpr size_t WS_END = 979 * MiB;
static_assert(WS_V - WS_K == WS_K - WS_Q, "Q | K | V equally spaced");
static_assert(WS_W2E + 8 * 7 * MiB <= WS_RCOS && WS_KAUG + 160 * 2048 * 16 <= WS_TOKE && WS_BLKE + 4096 <= WS_ROWG && WS_ROWG + MAXBLK * 256 * 4 <= WS_LSE && WS_LSE + 3 * (size_t)NTOK * 6 * 4 <= WS_HB, "ws map 1");
static_assert(WS_HB + (size_t)(NTOK + 1) * D * 2 <= WS_Q && WS_OX2 + (size_t)NTOK * 384 * 2 <= WS_END && WS_H + (size_t)NTOK * FF * 2 <= WS_END && WS_XG + (size_t)MAXBLK * 256 * D <= WS_Y && WS_Y + (size_t)MAXBLK * 256 * D <= WS_HCH && WS_HCH + (size_t)CHUNK_LAST * 256 * FF <= WS_XR && WS_OX2 + (size_t)NTOK * 384 * 2 <= WS_XR && WS_XR + (size_t)NTOK * D * 2 <= WS_END, "ws map 2");
constexpr int CW_BAR = 4096;
constexpr int CW_AQ0 = 8192, CW_AQ1 = 8192 + 512;
constexpr int RING_OFF = 0, RING_BYTES = 135168, LDSCTL_OFF = RING_BYTES, MISC_OFF = LDSCTL_OFF + 320, LDSX_OFF = RING_BYTES + 1024, LDS_BYTES = 147456;
static_assert(att::L_BYTES <= RING_BYTES && att::LD_BYTES <= RING_BYTES && pg8::STAGE_BYTES <= RING_BYTES && LDSX_OFF + 8192 <= LDS_BYTES, "LDS map");

#define GAS __attribute__((address_space(1)))
#define LAS __attribute__((address_space(3)))
typedef unsigned short bf16;
typedef unsigned v4u __attribute__((ext_vector_type(4)));
typedef unsigned v2u __attribute__((ext_vector_type(2)));
typedef float f32x4 __attribute__((ext_vector_type(4)));
#define RLX_AGENT __ATOMIC_RELAXED, __HIP_MEMORY_SCOPE_AGENT
#define LDS_WAIT() asm volatile("s_waitcnt lgkmcnt(0)" ::: "memory")
#ifndef STG_QKV
#define STG_QKV 0
#endif
#ifndef STG_WO
#define STG_WO 0
#endif
#ifndef STG_UP
#define STG_UP 0
#endif
#ifndef STG_DN
#define STG_DN 0
#endif
#ifndef STG_MUP
#define STG_MUP 0
#endif
#ifndef STG_MDN
#define STG_MDN 0
#endif
#ifndef CLKP
#define CLKP -1
#endif
struct ClkStamp { unsigned long long t, r; };
__device__ __forceinline__ ClkStamp clk_begin() { ClkStamp s; s.t = __builtin_amdgcn_s_memtime(); s.r = __builtin_amdgcn_s_memrealtime(); return s; }
#ifndef CLK_BLOCK
#define CLK_BLOCK 0
#endif
#ifndef CLK_MODE
#define CLK_MODE 0
#endif
#ifndef CLK_ALL
#define CLK_ALL 0
#endif
__device__ __forceinline__ void clk_end(const ClkStamp& s) { if (CLK_ALL || blockIdx.x == CLK_BLOCK) { const unsigned long long t1 = __builtin_amdgcn_s_memtime(), r1 = __builtin_amdgcn_s_memrealtime();
    const unsigned long long mhz = CLK_MODE == 0 ? (t1 - s.t) * 100ull / (r1 - s.r) : (r1 - s.r) / 100ull; while (__builtin_amdgcn_s_memrealtime() - r1 < mhz * 100ull) __builtin_amdgcn_s_sleep(8); } }
#ifndef REV_DN
#define REV_DN 1
#endif
#ifndef REV_ATT
#define REV_ATT 1
#endif
#ifndef KST_ALL
#define KST_ALL 0
#endif
#ifndef KST_QKV0
#define KST_QKV0 0
#endif
#ifndef KST_UP0
#define KST_UP0 0
#endif
#ifndef QKV_MASK
#define QKV_MASK -1
#endif
#ifndef QKV_NMASK
#define QKV_NMASK 0xffff
#endif
struct MaskOrder : pg8::StaticOrder { int mask, nmask; __device__ bool next(int i, pg8::Unit& u) const { const bool r = pg8::StaticOrder::next(i, u); u.pm &= mask; u.pn &= nmask; return r; } };
__device__ __forceinline__ void stagger(int steps) { const int n = steps * (int)((blockIdx.x >> 3) & 3); for (int i = 0; i < n; ++i) __builtin_amdgcn_s_sleep(32); }
__device__ __forceinline__ unsigned pk2(float lo, float hi) { return pg8::cvt_pk_bf16(lo, hi); }
__device__ __forceinline__ float bf_lo(unsigned w) { return __uint_as_float(w << 16); }
__device__ __forceinline__ float bf_hi(unsigned w) { return __uint_as_float(w & 0xffff0000u); }
template <int CTRL> __device__ __forceinline__ float dpp_f(float v) { return __uint_as_float((unsigned)__builtin_amdgcn_update_dpp(0, (int)__float_as_uint(v), CTRL, 0xf, 0xf, true)); }
__device__ __forceinline__ float sum8(float v) {
    v += dpp_f<0xB1>(v); v += dpp_f<0x4E>(v); v += dpp_f<0x141>(v); return v; }
__device__ __forceinline__ float pair16(float x, float y) { const auto r = __builtin_amdgcn_permlane16_swap(__float_as_uint(x), __float_as_uint(y), false, false); return __uint_as_float(r[0]) + __uint_as_float(r[1]); }
__device__ __forceinline__ float pair32(float x, float y) { const auto r = __builtin_amdgcn_permlane32_swap(__float_as_uint(x), __float_as_uint(y), false, false); return __uint_as_float(r[0]) + __uint_as_float(r[1]); }
__device__ __forceinline__ float wave_sum(float v) { v = sum8(v); v += dpp_f<0x140>(v); v = pair16(v, v); return pair32(v, v); }

#define XB_TMO      128
#define XB_XCNT(j)  (256  + 64 * (j))
#define XB_XSUB(j)  (1280 + 64 * (j))
#define XB_XGEN(j)  (2304 + 64 * (j))
#define XB_TOP      3328
#define XB_TOPGEN   3392
#define XCD_BAR_WORDS 3456
#define XB_SPIN_CAP (1u << 18)

__device__ __forceinline__ unsigned xb_ld(unsigned* p)              { return __hip_atomic_load(p, __ATOMIC_RELAXED, __HIP_MEMORY_SCOPE_AGENT); }
__device__ __forceinline__ unsigned xb_add(unsigned* p, unsigned v) { return __hip_atomic_fetch_add(p, v, __ATOMIC_RELAXED, __HIP_MEMORY_SCOPE_AGENT); }
__device__ __forceinline__ unsigned xb_xcc_id() { return (unsigned)__builtin_amdgcn_s_getreg((3 << 11) | 20) & 0xFu; }
#define XB_SPIN(cond, bar) do { unsigned _sp = 0; while (cond) { __builtin_amdgcn_s_sleep(1); \
    if ((++_sp & 255u) == 0u) { if (xb_ld(&(bar)[XB_TMO])) break; if (_sp > XB_SPIN_CAP) { atomicAdd(&(bar)[XB_TMO], 1u); break; } } } } while (0)

struct XcdBarrier {
    unsigned* bar; unsigned x;
    volatile LAS unsigned* st;
};

__device__ __forceinline__ XcdBarrier xcd_barrier_post(unsigned* bar, volatile LAS unsigned* st, const int tid_x) {
    XcdBarrier b; b.bar = bar; b.x = xb_xcc_id(); b.st = st;
    if (tid_x == 0) (void)xb_add(&bar[XB_XCNT(b.x)], 1u);
    return b;
}
__device__ __forceinline__ void xcd_barrier_complete(unsigned* bar, unsigned x, unsigned& nloc, unsigned& nx) {
    const unsigned G = gridDim.x * gridDim.y * gridDim.z;
    unsigned sum, cnt, mine, sp = 0u;
    for (;;) {
        sum = 0u; cnt = 0u; mine = 0u;
#pragma unroll
        for (unsigned j = 0; j < 16; ++j) { const unsigned c = xb_ld(&bar[XB_XCNT(j)]); sum += c; cnt += (c > 0u) ? 1u : 0u; mine = (j == x) ? c : mine; }
        if (sum == G) break;
        __builtin_amdgcn_s_sleep(1);
        if ((++sp & 255u) == 0u) { if (xb_ld(&bar[XB_TMO])) break; if (sp > XB_SPIN_CAP) { atomicAdd(&bar[XB_TMO], 1u); break; } }
    }
    nloc = mine > 0u ? mine : 1u; nx = cnt > 0u ? cnt : 1u;
}

__device__ __forceinline__ void xcd_barrier(const XcdBarrier& b, const int tid_x) {
    asm volatile("s_waitcnt vmcnt(0)" ::: "memory");
    __syncthreads();
    if (tid_x == 0) {
        unsigned* bar = b.bar;
        __builtin_amdgcn_s_waitcnt(0);
        unsigned nloc = b.st[0], nx = b.st[1];
        if (nloc == 0u) { xcd_barrier_complete(bar, b.x, nloc, nx); b.st[0] = nloc; b.st[1] = nx; }
        const unsigned old = xb_add(&bar[XB_XSUB(b.x)], 1u);
        const unsigned gen = old / nloc;
        if (old + 1u == (gen + 1u) * nloc) {
            __builtin_amdgcn_fence(__ATOMIC_RELEASE, "agent");
            asm volatile("s_waitcnt vmcnt(0)" ::: "memory");
            const unsigned og = xb_add(&bar[XB_TOP], 1u);
            const unsigned tg = og / nx;
            if (og + 1u == (tg + 1u) * nx) xb_add(&bar[XB_TOPGEN], 1u);
            else XB_SPIN(xb_ld(&bar[XB_TOPGEN]) == tg, bar);
            __builtin_amdgcn_fence(__ATOMIC_ACQUIRE, "agent");
            xb_add(&bar[XB_XGEN(b.x)], 1u);
            asm volatile("s_waitcnt vmcnt(0)" ::: "memory");
        } else {
            XB_SPIN(xb_ld(&bar[XB_XGEN(b.x)]) == gen, bar);
            __builtin_amdgcn_fence(__ATOMIC_ACQUIRE, "agent");
            asm volatile("s_waitcnt vmcnt(0)" ::: "memory");
        }
    }
    __syncthreads();
}


__device__ __forceinline__ void tr_load(const float* W, int ld, int k0, int n0, LAS float* scr, int lane) {
    if ((ld & 3) == 0) {
        const int r = lane >> 3, c4 = lane & 7;
        f32x4 v[8];
#pragma unroll
        for (int i = 0; i < 8; ++i) v[i] = __builtin_nontemporal_load((const f32x4*)(W + (size_t)(k0 + 8 * i + r) * ld + n0 + 4 * c4));
#pragma unroll
        for (int i = 0; i < 8; ++i) { LAS float* d = scr + (4 * c4) * 68 + 8 * i + r; d[0] = v[i].x; d[68] = v[i].y; d[136] = v[i].z; d[204] = v[i].w; }
    } else {
#pragma unroll 8
        for (int i = 0; i < 32; ++i) { const int kk = 2 * i + (lane >> 5); scr[(lane & 31) * 68 + kk] = __builtin_nontemporal_load(W + (size_t)(k0 + kk) * ld + n0 + (lane & 31)); }
    }
    LDS_WAIT(); asm volatile("" ::: "memory");
}
__device__ __forceinline__ void tr_item(const float* W, int ld, int k0, int n0, bf16* WT, int Kd, int drow0, LAS float* scr, int lane, const bool swp = false, const float* kscale = nullptr, const int kdst = -1) {
    tr_load(W, ld, k0, n0, scr, lane);
    const int c = lane & 7;
    f32x4 ka = {1.f, 1.f, 1.f, 1.f}, kb = ka; if (kscale) { ka = *(const f32x4*)(kscale + k0 + 8 * c); kb = *(const f32x4*)(kscale + k0 + 8 * c + 4); }
#pragma unroll
    for (int j = 0; j < 4; ++j) { const int n = (lane >> 3) + 8 * j; const LAS f32x4* s = (const LAS f32x4*)(scr + n * 68 + 8 * c); const f32x4 a = s[0] * ka, b = s[1] * kb;
        v4u o; o.x = pk2(a.x, a.y); o.y = pk2(a.z, a.w); o.z = pk2(b.x, b.y); o.w = pk2(b.z, b.w);
        const int nd = (swp && ((n >> 2) == 1 || (n >> 2) == 2)) ? (n ^ 12) : n;
        *(v4u*)(WT + (size_t)(drow0 + nd) * Kd + (kdst >= 0 ? kdst : k0) + 8 * c) = o; }
    LDS_WAIT(); asm volatile("" ::: "memory");
}
__device__ __forceinline__ void tr_item8(const float* W, int ld, int k0, int n0, unsigned char* WT, int Kd, int drow0, float scale, LAS float* scr, int lane, const float* kscale = nullptr) {
    tr_load(W, ld, k0, n0, scr, lane);
    const int c = lane & 3;
    f32x4 k4[4] = {{scale, scale, scale, scale}, {scale, scale, scale, scale}, {scale, scale, scale, scale}, {scale, scale, scale, scale}};
    if (kscale) {
#pragma unroll
        for (int q = 0; q < 4; ++q) k4[q] = *(const f32x4*)(kscale + k0 + 16 * c + 4 * q) * scale; }
#pragma unroll
    for (int j = 0; j < 2; ++j) { const int n = (lane >> 2) + 16 * j; const LAS f32x4* s = (const LAS f32x4*)(scr + n * 68 + 16 * c); const f32x4 a = s[0] * k4[0], b = s[1] * k4[1], cc = s[2] * k4[2], d = s[3] * k4[3];
        v4u o; o.x = pg8::cvt_fp8x4(a.x, a.y, a.z, a.w); o.y = pg8::cvt_fp8x4(b.x, b.y, b.z, b.w); o.z = pg8::cvt_fp8x4(cc.x, cc.y, cc.z, cc.w); o.w = pg8::cvt_fp8x4(d.x, d.y, d.z, d.w);
        *(v4u*)(WT + (size_t)(drow0 + n) * Kd + k0 + 16 * c) = o; }
    LDS_WAIT(); asm volatile("" ::: "memory");
}
constexpr float XSCALE8 = 8.f; constexpr int XSCALE8_EXP = 3;
constexpr float WSCALE8 = 256.f; constexpr int WSCALE8_EXP = 8; constexpr float HSCALE8 = 8.f; constexpr int HSCALE8_EXP = 3; constexpr float YSCALE8 = 16.f;
struct In { const float* p[21]; };
constexpr int I_WIN = 16 * 96, I_WO = 16 * 32, I_W1 = 16 * 112, I_W2 = 56 * 32, I_FFN = 2 * I_W1 + I_W2, I_L0 = I_WIN + I_WO + I_FFN, I_L1A = I_WIN + I_WO, I_TOTAL = I_L0 + I_L1A + NEXP * I_FFN;
__device__ __forceinline__ void tr_ffn_item(int r, const float* w1, const float* w3, const float* w2, bf16* W13, bf16* W2T, LAS float* scr, int lane) {
    if (r < 2 * I_W1) { const bool up = r >= I_W1; if (up) r -= I_W1; const int kb = r / 112, nb = r % 112, n0 = 32 * nb;
        tr_item(up ? w3 : w1, FF, 64 * kb, n0, W13, D, 256 * (n0 >> 7) + (up ? 128 : 0) + (n0 & 127), scr, lane); }
    else { r -= 2 * I_W1; const int kb = r / 32, nb = r % 32; tr_item(w2, D, 64 * kb, 32 * nb, W2T, FF, 32 * nb, scr, lane); }
}
__device__ __forceinline__ void tr_ffn_item8(int r, const float* w1, const float* w3, const float* w2, unsigned char* W13, unsigned char* W2T, LAS float* scr, int lane, const float* kscale = nullptr) {
    if (r < 2 * I_W1) { const bool up = r >= I_W1; if (up) r -= I_W1; const int kb = r / 112, nb = r % 112, n0 = 32 * nb;
        tr_item8(up ? w3 : w1, FF, 64 * kb, n0, W13, D, 256 * (n0 >> 7) + (up ? 128 : 0) + (n0 & 127), WSCALE8, scr, lane, kscale); }
    else { r -= 2 * I_W1; const int kb = r / 32, nb = r % 32; tr_item8(w2, D, 64 * kb, 32 * nb, W2T, FF, 32 * nb, WSCALE8, scr, lane); }
}
__device__ __forceinline__ void tr_win_item(const float* w_in, int r, unsigned char* dst, LAS float* scr, int lane, const float* kscale = nullptr) {
    const int k0 = 64 * (r / 96), n0 = 32 * (r % 96);
    tr_item(w_in, WIN_LD, k0, n0, (bf16*)dst, D, n0, scr, lane, n0 < 2 * D && (n0 & 63) == 0, kscale);
}
struct CvItem { const float* W; unsigned char* WT; int ld, k0, n0, Kd, drow0; };
__device__ __forceinline__ CvItem cv_decode(const In& in, unsigned char* ws, int idx) {
    CvItem c; const int e = idx / I_FFN; int r = idx - e * I_FFN;
    if (r < 2 * I_W1) { const bool up = r >= I_W1; if (up) r -= I_W1; const int kb = r / 112, nb = r % 112, n0 = 32 * nb;
        c.W = (up ? in.p[18] : in.p[17]) + (size_t)e * D * FF; c.ld = FF; c.k0 = 64 * kb; c.n0 = n0; c.WT = ws + WS_W13E + (size_t)e * 2 * FF * D; c.Kd = D; c.drow0 = 256 * (n0 >> 7) + (up ? 128 : 0) + (n0 & 127); }
    else { r -= 2 * I_W1; const int kb = r / 32, nb = r % 32; c.W = in.p[19] + (size_t)e * FF * D; c.ld = D; c.k0 = 64 * kb; c.n0 = 32 * nb; c.WT = ws + WS_W2E + (size_t)e * D * FF; c.Kd = FF; c.drow0 = 32 * nb; }
    return c;
}
__device__ __forceinline__ void cv_issue(const CvItem& c, f32x4 (&v)[8], int lane) { const int r = lane >> 3, c4 = lane & 7;
#pragma unroll
    for (int i = 0; i < 8; ++i) v[i] = __builtin_nontemporal_load((const f32x4*)(c.W + (size_t)(c.k0 + 8 * i + r) * c.ld + c.n0 + 4 * c4)); }
__device__ __forceinline__ void cv_finish(const CvItem& c, const f32x4 (&v)[8], LAS float* scr, int lane) { const int r = lane >> 3, c4 = lane & 7;
#pragma unroll
    for (int i = 0; i < 8; ++i) { LAS float* d = scr + (4 * c4) * 68 + 8 * i + r; d[0] = v[i].x; d[68] = v[i].y; d[136] = v[i].z; d[204] = v[i].w; }
    LDS_WAIT(); asm volatile("" ::: "memory");
    const int cc = lane & 3;
#pragma unroll
    for (int j = 0; j < 2; ++j) { const int n = (lane >> 2) + 16 * j; const LAS f32x4* s = (const LAS f32x4*)(scr + n * 68 + 16 * cc); const f32x4 a = s[0] * WSCALE8, b = s[1] * WSCALE8, c2 = s[2] * WSCALE8, d2 = s[3] * WSCALE8;
        v4u o; o.x = pg8::cvt_fp8x4(a.x, a.y, a.z, a.w); o.y = pg8::cvt_fp8x4(b.x, b.y, b.z, b.w); o.z = pg8::cvt_fp8x4(c2.x, c2.y, c2.z, c2.w); o.w = pg8::cvt_fp8x4(d2.x, d2.y, d2.z, d2.w);
        *(v4u*)(c.WT + (size_t)(c.drow0 + n) * c.Kd + c.k0 + 16 * cc) = o; }
    LDS_WAIT(); asm volatile("" ::: "memory");
}
__device__ __forceinline__ void transpose_all(const In& in, unsigned char* ws, LAS float* scr, int gw, int NGW, int lane) {
    { constexpr int NE = NEXP * I_FFN;
      if (gw < NE) { CvItem cur = cv_decode(in, ws, gw); f32x4 va[8]; cv_issue(cur, va, lane);
#pragma unroll 1
        for (int idx = gw; idx < NE; idx += NGW) { const int nidx = idx + NGW; CvItem nxt = cur; f32x4 vb[8];
            if (nidx < NE) { nxt = cv_decode(in, ws, nidx); cv_issue(nxt, vb, lane); }
            cv_finish(cur, va, scr, lane);
            cur = nxt;
#pragma unroll
            for (int i = 0; i < 8; ++i) va[i] = vb[i]; } } }
    for (int it = gw; it < I_TOTAL - NEXP * I_FFN; it += NGW) {
        int r = it;
        if (r < I_L0) {
            if (r < I_WIN) { tr_win_item(in.p[2], r, ws + WS_WIN0, scr, lane, in.p[1]); continue; } r -= I_WIN;
            if (r < I_WO) { const int hk = r / 32; tr_item(in.p[5], D, 64 * hk, 32 * (r % 32), (bf16*)(ws + WS_WOUT0), D, 32 * (r % 32), scr, lane, false, hk < 10 ? in.p[4] : nullptr, att::colofs(hk)); continue; } r -= I_WO;
            if (DENSE_FP8) tr_ffn_item8(r, in.p[7], in.p[8], in.p[9], ws + WS_W13_0, ws + WS_W2_0, scr, lane, in.p[6]);
            else tr_ffn_item(r, in.p[7], in.p[8], in.p[9], (bf16*)(ws + WS_W13_0), (bf16*)(ws + WS_W2_0), scr, lane);
            continue; }
        r -= I_L0;
        if (r < I_WIN) { tr_win_item(in.p[11], r, ws + WS_WIN1, scr, lane, in.p[10]); continue; } r -= I_WIN;
        if (r < I_WO) { const int hk = r / 32; tr_item(in.p[14], D, 64 * hk, 32 * (r % 32), (bf16*)(ws + WS_WOUT1), D, 32 * (r % 32), scr, lane, false, hk < 10 ? in.p[13] : nullptr, att::colofs(hk)); continue; } r -= I_WO;
        const int e = r / I_FFN; r -= e * I_FFN;
        tr_ffn_item8(r, in.p[17] + (size_t)e * D * FF, in.p[18] + (size_t)e * D * FF, in.p[19] + (size_t)e * FF * D, ws + WS_W13E + (size_t)e * 2 * FF * D, ws + WS_W2E + (size_t)e * D * FF, scr, lane);
    }
}

template <int MODE, bool OUT8, bool INB16>
__device__ __forceinline__ void norm_phase(const void* X, const float* gain, void* HBv, const float* wx, int wx_ld, int wx_c0, const float* bfp, float* LF,
                                           int* TOKE, float* TOKG, int* HIST, LAS unsigned char* lds, int tid, int lane, int wave, float* RSTD = nullptr, bf16* XRAW = nullptr) {
    constexpr int NX = MODE == 1 ? 5 : (MODE == 2 ? 8 : 0);
#define NP_COL(jj, cc) (INB16 ? (16 * lane + 4 * (jj) + (cc)) : (256 * (jj) + 4 * lane + (cc)))
    f32x4 g[4];
#pragma unroll
    for (int j = 0; j < 4; ++j) g[j] = *(const f32x4*)(gain + NP_COL(j, 0));
    f32x4 gw[NX > 0 ? NX : 1][4];
#pragma unroll
    for (int e = 0; e < NX; ++e)
#pragma unroll
        for (int j = 0; j < 4; ++j)
#pragma unroll
            for (int c = 0; c < 4; ++c) gw[e][j][c] = g[j][c] * wx[(size_t)NP_COL(j, c) * wx_ld + wx_c0 + e];
    float bias_l = 0.f; if (MODE == 1) { const int e = (lane >> 3) & 7; bias_l = bfp[e < 5 ? e : 0]; }
    LAS int* lh = (LAS int*)(lds + LDSX_OFF);
    for (int rbk = blockIdx.x; rbk < NRB; rbk += gridDim.x) {
        if (MODE == 2) { if (tid < 8) lh[tid] = 0; __syncthreads(); }
        struct Raw { v4u w0, w1; f32x4 x[INB16 ? 1 : 4]; };
        auto load_raw = [&](int row, Raw& r) {
            if constexpr (INB16) { const v4u* xr = (const v4u*)((const bf16*)X + (size_t)row * D + 16 * lane); r.w0 = xr[0]; r.w1 = xr[1]; }
            else { const f32x4* xr = (const f32x4*)((const float*)X + (size_t)row * D) + lane;
#pragma unroll
                for (int j = 0; j < 4; ++j) r.x[j] = __builtin_nontemporal_load(xr + 64 * j); } };
        const int rowb = rbk * 256 + wave * 32;
        Raw n1, n2; load_raw(rowb, n1); load_raw(rowb + 1, n2);
        for (int i = 0; i < 32; ++i) {
            const int row = rowb + i;
            const Raw cr = n1; n1 = n2;
            if (i + 2 < 32) load_raw(row + 2, n2);
            f32x4 v[4]; float ss = 0.f;
            if constexpr (INB16) { const v4u w0 = cr.w0, w1 = cr.w1;
                v[0] = (f32x4){bf_lo(w0.x), bf_hi(w0.x), bf_lo(w0.y), bf_hi(w0.y)}; v[1] = (f32x4){bf_lo(w0.z), bf_hi(w0.z), bf_lo(w0.w), bf_hi(w0.w)};
                v[2] = (f32x4){bf_lo(w1.x), bf_hi(w1.x), bf_lo(w1.y), bf_hi(w1.y)}; v[3] = (f32x4){bf_lo(w1.z), bf_hi(w1.z), bf_lo(w1.w), bf_hi(w1.w)}; }
            else {
#pragma unroll
                for (int j = 0; j < 4; ++j) v[j] = cr.x[j]; }
#pragma unroll
            for (int j = 0; j < 4; ++j) ss += (v[j].x * v[j].x + v[j].y * v[j].y) + (v[j].z * v[j].z + v[j].w * v[j].w);
            const float rstd = __builtin_amdgcn_rsqf(wave_sum(ss) * (1.f / D) + EPS);
            f32x4 h[4];
#pragma unroll
            for (int j = 0; j < 4; ++j) h[j] = v[j] * rstd * g[j];
            if (RSTD) { if (lane == 0) RSTD[row] = rstd;
                if constexpr (!INB16) { if (XRAW) {
#pragma unroll
                    for (int j = 0; j < 4; ++j) ((unsigned long long*)(XRAW + (size_t)row * D))[64 * j + lane] = (unsigned long long)pk2(v[j].x, v[j].y) | ((unsigned long long)pk2(v[j].z, v[j].w) << 32); } } }
            else if constexpr (INB16) {
                if (OUT8) { v4u o; o.x = pg8::cvt_fp8x4(h[0].x, h[0].y, h[0].z, h[0].w); o.y = pg8::cvt_fp8x4(h[1].x, h[1].y, h[1].z, h[1].w); o.z = pg8::cvt_fp8x4(h[2].x, h[2].y, h[2].z, h[2].w); o.w = pg8::cvt_fp8x4(h[3].x, h[3].y, h[3].z, h[3].w);
                    pg8::st16w((unsigned char*)HBv + (size_t)row * D + 16 * lane, o); }
                else { v4u o0, o1; o0.x = pk2(h[0].x, h[0].y); o0.y = pk2(h[0].z, h[0].w); o0.z = pk2(h[1].x, h[1].y); o0.w = pk2(h[1].z, h[1].w); o1.x = pk2(h[2].x, h[2].y); o1.y = pk2(h[2].z, h[2].w); o1.z = pk2(h[3].x, h[3].y); o1.w = pk2(h[3].z, h[3].w);
                    v4u* d = (v4u*)((bf16*)HBv + (size_t)row * D + 16 * lane); pg8::st16w(d, o0); pg8::st16w(d + 1, o1); }
            } else {
#pragma unroll
                for (int j = 0; j < 4; ++j) {
                    if (OUT8) ((unsigned*)((unsigned char*)HBv + (size_t)row * D))[64 * j + lane] = pg8::cvt_fp8x4(h[j].x, h[j].y, h[j].z, h[j].w);
                    else ((unsigned long long*)((bf16*)HBv + (size_t)row * D))[64 * j + lane] = (unsigned long long)pk2(h[j].x, h[j].y) | ((unsigned long long)pk2(h[j].z, h[j].w) << 32); }
            }
            if (NX > 0) {
                float a8[8];
#pragma unroll
                for (int e = 0; e < 8; ++e) { float a = 0.f;
                    if (e < NX) { typedef float f32x2_t __attribute__((ext_vector_type(2))); f32x2_t a2 = {0.f, 0.f};
#pragma unroll
                        for (int j = 0; j < 4; ++j) { a2 = (f32x2_t){v[j].x, v[j].y} * (f32x2_t){gw[e][j].x, gw[e][j].y} + a2; a2 = (f32x2_t){v[j].z, v[j].w} * (f32x2_t){gw[e][j].z, gw[e][j].w} + a2; }
                        a = a2.x + a2.y; }
                    a8[e] = a; }
                float a4[4], a2[2], zl;
#pragma unroll
                for (int q = 0; q < 4; ++q) a4[q] = pair32(a8[q], a8[q + 4]);
#pragma unroll
                for (int q = 0; q < 2; ++q) a2[q] = pair16(a4[q], a4[q + 2]);
                { const bool up = (lane & 8) != 0; const float keep = up ? a2[1] : a2[0], send = up ? a2[0] : a2[1]; zl = keep + dpp_f<0x128>(send); }
                zl = sum8(zl);
                zl *= rstd;
                if (MODE == 1) {
                    const int b = row >> 11, s = row & 2047, e = (lane >> 3) & 7;
                    const float zz = zl + bias_l; const float ls = fminf(zz, 0.f) - 0.6931471805599453f * __builtin_amdgcn_logf(1.f + __builtin_amdgcn_exp2f(-1.4426950408889634f * fabsf(zz)));
                    if ((lane & 7) == 0 && e < 5) LF[(size_t)(b * 5 + e) * SEQ + s] = ls;
                } else if (MODE == 2) {
                    float z[8];
#pragma unroll
                    for (int e = 0; e < 8; ++e) z[e] = __uint_as_float(__builtin_amdgcn_readlane(__float_as_uint(zl), 8 * e));
                    int e1 = 0; float v1 = z[0];
#pragma unroll
                    for (int e = 1; e < NX; ++e) if (z[e] > v1) { v1 = z[e]; e1 = e; }
                    int e2 = -1; float v2 = -INFINITY;
#pragma unroll
                    for (int e = 0; e < NX; ++e) if (e != e1 && z[e] > v2) { v2 = z[e]; e2 = e; }
                    const float g1 = __builtin_amdgcn_rcpf(1.f + __builtin_amdgcn_exp2f(1.4426950408889634f * (v2 - v1))), g2 = 1.f - g1;
                    if (lane == 0) { TOKE[row] = e1 | (e2 << 8); TOKG[2 * row] = g1; TOKG[2 * row + 1] = g2; __hip_atomic_fetch_add(&lh[e1], 1, __ATOMIC_RELAXED, __HIP_MEMORY_SCOPE_WORKGROUP); __hip_atomic_fetch_add(&lh[e2], 1, __ATOMIC_RELAXED, __HIP_MEMORY_SCOPE_WORKGROUP); }
                }
            }
        }
        if (MODE == 2) { __syncthreads(); if (tid < 8) HIST[rbk * 8 + tid] = lh[tid]; __syncthreads(); }
    }
#undef NP_COL
}

__device__ __forceinline__ unsigned f2bf_bits(float f) { return pk2(f, 0.f) & 0xffffu; }
__device__ __forceinline__ void kaug_item(const float* LF, v4u* KAUG, int it, int lane) {
    const float* src = LF + (size_t)it * SEQ + 32 * lane; float v[32];
#pragma unroll
    for (int q = 0; q < 8; ++q) { const f32x4 x = *(const f32x4*)(src + 4 * q); v[4 * q] = x.x; v[4 * q + 1] = x.y; v[4 * q + 2] = x.z; v[4 * q + 3] = x.w; }
#pragma unroll
    for (int q = 1; q < 32; ++q) v[q] += v[q - 1];
    float incl = v[31];
#pragma unroll
    for (int o = 1; o < 64; o <<= 1) { const float t = __shfl_up(incl, o); if (lane >= o) incl += t; }
    const float excl = incl - v[31];
    v4u* dst = KAUG + (size_t)it * SEQ + 32 * lane;
#pragma unroll
    for (int q = 0; q < 32; ++q) { const float x = -(excl + v[q]) * 1.4426950408889634f;
        const unsigned h1 = f2bf_bits(x); const float r1 = x - __uint_as_float(h1 << 16);
        const unsigned h2 = f2bf_bits(r1); const float r2 = r1 - __uint_as_float(h2 << 16);
        const unsigned h3 = f2bf_bits(r2);
        v4u o; o.x = h1 | (h2 << 16); o.y = h3 | 0x3f800000u; o.z = 0x3f803f80u; o.w = 0u; dst[q] = o; }
}
constexpr int KMEAN_FLOATS = 160 * 8 * 64;

constexpr int NU_AB = 2 * 160 * 8, NU_C = 192 * 24, NU_ATT = NU_AB + NU_C, NPAIR = 2 * 160 * 4;
__device__ __forceinline__ void attn_phase(const att::Tens& T, LAS unsigned char* lds, int wave, unsigned* aq, const int do_ab = 1, const int do_c = 1) {
    const int G = gridDim.x, x = blockIdx.x & 7, l = blockIdx.x >> 3, LX = G >> 3;
    if ((G & 7) == 0 && LX >= 4) {
        const int ngrp = LX >> 2, g = l >> 2, m = l & 3;
        if (do_ab && g < ngrp) for (int s = g * 8 + x; s < 320; s += ngrp * 8) { const int ty = s / 160, bh = s % 160, bi = bh / 5, b = REV_ATT ? 4 * (bi & 7) + 3 - (bi >> 3) : bi, h5 = bh % 5;
#pragma unroll 1
            for (int half = 0; half < 2; ++half) { const int qb = half ? m : 7 - m;
                if (ty == 0) att::unit_ring<true>(b, h5, qb, T, (LAS char*)(lds + RING_OFF), wave);
                else att::unit_ring<false>(b, 5 + h5, qb, T, (LAS char*)(lds + RING_OFF), wave); } }
        if (do_c) att::win_units(l, LX, (24 * 24 - l + LX - 1) / LX, x, T, (LAS char*)(lds + RING_OFF), wave);
    } else {
        const int c = blockIdx.x;
        if (do_ab) for (int p = c; p < NPAIR; p += G) { const int pt = p / 320, rem = p % 320, ty = rem / 160, bh = rem % 160, b = bh / 5, h5 = bh % 5;
#pragma unroll 1
            for (int half = 0; half < 2; ++half) { const int qb = half ? pt : 7 - pt;
                if (ty == 0) att::unit_ring<true>(b, h5, qb, T, (LAS char*)(lds + RING_OFF), wave);
                else att::unit_ring<false>(b, 5 + h5, qb, T, (LAS char*)(lds + RING_OFF), wave); } }
        if (do_c) for (int j = c; j < NU_C; j += G) { const int bh = j / 24, k = j % 24, b = bh / 6, h = 10 + bh % 6;
            int type, a0, a1 = 0;
            if (k < 8) { type = att::T_D1; a0 = k; } else if (k < 16) { type = att::T_D4; a0 = (k - 8) >> 2; a1 = (k - 8) & 3; } else { type = att::T_D16; a0 = k - 16; }
            att::unit_win(type, b, h, a0, a1, T, (LAS char*)(lds + RING_OFF), wave); }
    }
}

__device__ __forceinline__ void mixnorm_phase(bf16* O, const bf16* OX1, const bf16* OX2, const float* LSE, const float* mgain, const float* SSQ, float* RAB, int gw, int NGW, int lane) {
    const bool act = lane < 48; const int lc = act ? lane : 0, hc = lc >> 3;
    const int ocol = att::colofs(10 + hc) + (lc & 7) * 8;
    const f32x4 g0 = *(const f32x4*)(mgain + 640 + 8 * lc), g1 = *(const f32x4*)(mgain + 640 + 8 * lc + 4);
    struct Raw { v4u w, a, b; float L0, L1, L2, q; };
    auto load_row = [&](int row, Raw& r) {
        r.w = *(const v4u*)(O + (size_t)row * D + ocol); r.a = __builtin_nontemporal_load((const v4u*)(OX1 + (size_t)row * 384 + 8 * lc)); r.b = __builtin_nontemporal_load((const v4u*)(OX2 + (size_t)row * 384 + 8 * lc));
        r.L0 = LSE[(size_t)row * 6 + hc]; r.L1 = LSE[((size_t)NTOK + row) * 6 + hc]; r.L2 = LSE[((size_t)2 * NTOK + row) * 6 + hc];
        r.q = SSQ[(size_t)row * 16 + (lane & 15)]; };
    Raw n1, n2; if (gw < NTOK) load_row(gw, n1); if (gw + NGW < NTOK) load_row(gw + NGW, n2);
    for (int row = gw; row < NTOK; row += NGW) {
        const Raw r = n1; n1 = n2;
        if (row + 2 * NGW < NTOK) load_row(row + 2 * NGW, n2);
        float f[8];
        const float mx = fmaxf(r.L0, fmaxf(r.L1, r.L2));
        float w0 = __builtin_amdgcn_exp2f(r.L0 - mx), w1 = __builtin_amdgcn_exp2f(r.L1 - mx), w2 = __builtin_amdgcn_exp2f(r.L2 - mx);
        const float inv = __builtin_amdgcn_rcpf(w0 + w1 + w2); w0 *= inv; w1 *= inv; w2 *= inv;
#define MIXC(i, k, hi_) f[i] = w0 * (hi_ ? bf_hi(r.w.k) : bf_lo(r.w.k)) + w1 * (hi_ ? bf_hi(r.a.k) : bf_lo(r.a.k)) + w2 * (hi_ ? bf_hi(r.b.k) : bf_lo(r.b.k))
        MIXC(0, x, 0); MIXC(1, x, 1); MIXC(2, y, 0); MIXC(3, y, 1); MIXC(4, z, 0); MIXC(5, z, 1); MIXC(6, w, 0); MIXC(7, w, 1);
#undef MIXC
        float ss = 0.f;
#pragma unroll
        for (int i = 0; i < 8; ++i) ss += f[i] * f[i];
        const float sC = wave_sum(act ? ss : 0.f);
        const int hl = lane & 15; const float qa = (lane < 16 && hl < 5) ? r.q : 0.f, qb = (lane < 16 && hl >= 5 && hl < 10) ? r.q : 0.f;
        const float sA = wave_sum(qa), sB = wave_sum(qb);
        const float rA = __builtin_amdgcn_rsqf(sA * (1.f / 320.f) + EPS), rB = __builtin_amdgcn_rsqf(sB * (1.f / 320.f) + EPS), rC = __builtin_amdgcn_rsqf(sC * (1.f / 384.f) + EPS);
        const float sc = rC * (hc == 0 ? __builtin_amdgcn_sqrtf(sA * (1.f / 320.f) + EPS) : (hc == 1 ? __builtin_amdgcn_sqrtf(sB * (1.f / 320.f) + EPS) : 1.f));
        v4u o;
        o.x = pk2(f[0] * sc * g0.x, f[1] * sc * g0.y); o.y = pk2(f[2] * sc * g0.z, f[3] * sc * g0.w); o.z = pk2(f[4] * sc * g1.x, f[5] * sc * g1.y); o.w = pk2(f[6] * sc * g1.z, f[7] * sc * g1.w);
        if (act) pg8::st16w(O + (size_t)row * D + ocol, o);
        if (lane == 0) { RAB[2 * (size_t)row] = rA * __builtin_amdgcn_rcpf(rB); RAB[2 * (size_t)row + 1] = rB; }
    }
}

__device__ __forceinline__ void scatter_phase(const int* TOKE, const float* TOKG, const int* HIST, int* TOKS, float* ROWG, int* META, int* BLKE, const bf16* HB, bf16* XG,
                                              LAS unsigned char* lds, int tid, int lane, int wave) {
    LAS int* L = (LAS int*)(lds + LDSX_OFF);
    for (int rbk = blockIdx.x; rbk < NRB; rbk += gridDim.x) {
        if (tid < 32) L[tid] = 0;
        __syncthreads();
        { const int e = tid & 7, part = tid >> 3; int p = 0, tt = 0;
#pragma unroll
          for (int q = 0; q < 4; ++q) { const int r2 = part * 4 + q; const int v = HIST[r2 * 8 + e]; tt += v; if (r2 < rbk) p += v; }
          __hip_atomic_fetch_add(&L[e], p, __ATOMIC_RELAXED, __HIP_MEMORY_SCOPE_WORKGROUP); __hip_atomic_fetch_add(&L[8 + e], tt, __ATOMIC_RELAXED, __HIP_MEMORY_SCOPE_WORKGROUP); }
        __syncthreads();
        if (tid == 0) { int ps = 0;
            for (int e = 0; e < 8; ++e) { L[16 + e] = ps; ps += (L[8 + e] + 255) & ~255; }
            L[24] = ps >> 8; }
        __syncthreads();
        if (wave == 0) {
            int run[8] = {0, 0, 0, 0, 0, 0, 0, 0};
            for (int j = 0; j < 8; ++j) { const int a = 64 * j + lane, t = rbk * 256 + (a >> 1), k = a & 1; const int e = (TOKE[t] >> (8 * k)) & 0xff; int rank = 0;
#pragma unroll
                for (int e2 = 0; e2 < 8; ++e2) { const unsigned long long m = __ballot(e == e2); if (e == e2) rank = run[e2] + __popcll(m & ((1ull << lane) - 1ull)); run[e2] += __popcll(m); }
                const int dest = L[16 + e] + L[e] + rank;
                ROWG[dest] = TOKG[2 * t + k]; TOKS[2 * t + k] = dest; L[32 + a] = dest; }
        }
        __syncthreads();
        for (int i = 0; i < 64; i += 8) { v4u x[8]; int dest[8];
#pragma unroll
            for (int q = 0; q < 8; ++q) { const int a = wave * 64 + i + q, t = rbk * 256 + (a >> 1); dest[q] = L[32 + a]; x[q] = *((const v4u*)((const unsigned char*)HB + (size_t)t * D) + lane); }
#pragma unroll
            for (int q = 0; q < 8; ++q) pg8::st16w((v4u*)((unsigned char*)XG + (size_t)dest[q] * D) + lane, x[q]); }
        if (rbk == 0) {
            for (int e = 0; e < 8; ++e) { const int st = L[16 + e], tot = L[8 + e], pad = ((tot + 255) & ~255) - tot;
                for (int i = wave; i < pad; i += NWAVES) { v4u* dst = (v4u*)((unsigned char*)XG + (size_t)(st + tot + i) * D) + lane; const v4u zz = {0u, 0u, 0u, 0u}; dst[0] = zz; if (lane == 0) ROWG[st + tot + i] = 0.f; }
                const int nb = (tot + 255) >> 8; for (int i = tid; i < nb; i += NWAVES * 64) BLKE[(st >> 8) + i] = e; }
            if (tid == 0) META[0] = L[24];
        }
        __syncthreads();
    }
}

__device__ __forceinline__ void final_phase(const bf16* XR, float* out, const unsigned char* Y8, const int* TOKS, const float* gain, int gw, int NGW, int lane) {
    f32x4 g[4];
#pragma unroll
    for (int j = 0; j < 4; ++j) g[j] = *(const f32x4*)(gain + 16 * lane + 4 * j);
    struct Raw { v4u w0, w1, ya, yb; };
    auto load_slots = [&](int row, int& s0, int& s1) { s0 = TOKS[2 * row]; s1 = TOKS[2 * row + 1]; };
    auto load_data = [&](int row, int s0, int s1, Raw& r) { const v4u* xr = (const v4u*)(XR + (size_t)row * D + 16 * lane); r.w0 = __builtin_nontemporal_load(xr); r.w1 = __builtin_nontemporal_load(xr + 1);
        r.ya = __builtin_nontemporal_load((const v4u*)(Y8 + (size_t)s0 * D + 16 * lane)); r.yb = __builtin_nontemporal_load((const v4u*)(Y8 + (size_t)s1 * D + 16 * lane)); };
    int sa0 = 0, sa1 = 0, sb0 = 0, sb1 = 0; Raw nx;
    if (gw < NTOK) { load_slots(gw, sa0, sa1); load_data(gw, sa0, sa1, nx); }
    if (gw + NGW < NTOK) load_slots(gw + NGW, sb0, sb1);
    for (int row = gw; row < NTOK; row += NGW) {
        const Raw r = nx; const int c0 = sb0, c1 = sb1;
        if (row + 2 * NGW < NTOK) load_slots(row + 2 * NGW, sb0, sb1);
        if (row + NGW < NTOK) load_data(row + NGW, c0, c1, nx);
        const v4u w0 = r.w0, w1 = r.w1, ya = r.ya, yb = r.yb;
        f32x4 v[4];
        v[0] = (f32x4){bf_lo(w0.x), bf_hi(w0.x), bf_lo(w0.y), bf_hi(w0.y)}; v[1] = (f32x4){bf_lo(w0.z), bf_hi(w0.z), bf_lo(w0.w), bf_hi(w0.w)};
        v[2] = (f32x4){bf_lo(w1.x), bf_hi(w1.x), bf_lo(w1.y), bf_hi(w1.y)}; v[3] = (f32x4){bf_lo(w1.z), bf_hi(w1.z), bf_lo(w1.w), bf_hi(w1.w)};
        float ss = 0.f;
#pragma unroll
        for (int j = 0; j < 4; ++j) { const unsigned a = ya[j], b = yb[j];
            v[j].x += (__builtin_amdgcn_cvt_f32_fp8(a, 0) + __builtin_amdgcn_cvt_f32_fp8(b, 0)) * (1.f / YSCALE8); v[j].y += (__builtin_amdgcn_cvt_f32_fp8(a, 1) + __builtin_amdgcn_cvt_f32_fp8(b, 1)) * (1.f / YSCALE8);
            v[j].z += (__builtin_amdgcn_cvt_f32_fp8(a, 2) + __builtin_amdgcn_cvt_f32_fp8(b, 2)) * (1.f / YSCALE8); v[j].w += (__builtin_amdgcn_cvt_f32_fp8(a, 3) + __builtin_amdgcn_cvt_f32_fp8(b, 3)) * (1.f / YSCALE8);
            ss += (v[j].x * v[j].x + v[j].y * v[j].y) + (v[j].z * v[j].z + v[j].w * v[j].w); }
        const float rstd = __builtin_amdgcn_rsqf(wave_sum(ss) * (1.f / D) + EPS);
        f32x4* o = (f32x4*)(out + (size_t)row * D + 16 * lane);
#pragma unroll
        for (int j = 0; j < 4; ++j) o[j] = v[j] * rstd * g[j];
    }
}

struct Args { In in; float* out; unsigned char* ws; int ph_lo, ph_hi; int probe_rt, pad; };
__global__ void __launch_bounds__(NWAVES * 64, 2) mk_fwd(Args args) {
    extern __shared__ __attribute__((aligned(16))) unsigned char lds_raw[];
    LAS unsigned char* lds = (LAS unsigned char*)lds_raw;
    volatile LAS unsigned* MISC = (volatile LAS unsigned*)(lds + MISC_OFF);
    const int tid0 = threadIdx.x, wave = __builtin_amdgcn_readfirstlane(tid0 >> 6);
    const int G = gridDim.x, gw = blockIdx.x * NWAVES + wave, NGW = G * NWAVES;
    unsigned char* ws = args.ws; const In& in = args.in; float* out = args.out;
    unsigned* ctl = (unsigned*)(ws + WS_CTL);
    for (int u = tid0; u < (LDS_BYTES - LDSCTL_OFF) / 4; u += NWAVES * 64) ((LAS unsigned*)(lds + LDSCTL_OFF))[u] = 0u;
    __syncthreads();
#if MK_ONE_LAUNCH
    XcdBarrier bar = xcd_barrier_post(ctl + CW_BAR, MISC + 8, tid0);
#define GRID_BAR() xcd_barrier(bar, wave * 64 + fresh_lane())
#else
#define GRID_BAR() do {} while (0)
#endif
    const int lo = args.ph_lo, hi = args.ph_hi;
#ifndef PHASE_ON
#define PHASE_ON(k) 1
#endif
#define IN(k) (PHASE_ON(k) && lo <= (k) && (k) < hi)
#ifndef PROBE_PHASE
#define PROBE_PHASE -1
#endif
#ifndef PROBE_RT
#define PROBE_RT 0
#endif
#ifndef PROBE_ATT_MODE
#define PROBE_ATT_MODE 0
#endif
#ifndef PROBE_ATT_AB
#define PROBE_ATT_AB 1
#define PROBE_ATT_C 1
#endif
#ifndef CLKACC_MASK
#define CLKACC_MASK 0ull
#endif
#ifndef CLKACC_SEAM
#define CLKACC_SEAM 0
#endif
    unsigned long long clk_acc = 0; (void)clk_acc;
#define ACC_ON(k) (((CLKACC_MASK) >> (k)) & 1ull)
#define SEAM(k) do { if (IN((k) + 1)) { if (ACC_ON(k) && CLKACC_SEAM) { const unsigned long long r0_ = __builtin_amdgcn_s_memrealtime(); GRID_BAR(); clk_acc += __builtin_amdgcn_s_memrealtime() - r0_; } else GRID_BAR(); } } while (0)
#define ACC_BEGIN(k) const unsigned long long ra_ = (ACC_ON(k) && !CLKACC_SEAM) ? __builtin_amdgcn_s_memrealtime() : 0ull
#define ACC_END(k) do { if (ACC_ON(k) && !CLKACC_SEAM) clk_acc += __builtin_amdgcn_s_memrealtime() - ra_; } while (0)
    bf16* HB = (bf16*)(ws + WS_HB); bf16* Qb = (bf16*)(ws + WS_Q); bf16* Kb = (bf16*)(ws + WS_K); bf16* Vb = (bf16*)(ws + WS_V);
    bf16* OX1 = (bf16*)(ws + WS_OX1); bf16* OX2 = (bf16*)(ws + WS_OX2); float* LSE = (float*)(ws + WS_LSE);
    float* LF = (float*)(ws + WS_LF); v4u* KAUG = (v4u*)(ws + WS_KAUG); float* KMEAN = (float*)(ws + WS_KMEAN);
    float* RSTD = (float*)(ws + WS_RSTD); unsigned long long* SS = (unsigned long long*)(ws + WS_SS); float* SSQ = (float*)(ws + WS_SSQ); float* RAB = (float*)(ws + WS_RAB);
    int* TOKE = (int*)(ws + WS_TOKE); float* TOKG = (float*)(ws + WS_TOKG); int* TOKS = (int*)(ws + WS_TOKS); int* HIST = (int*)(ws + WS_HIST); int* META = (int*)(ws + WS_META); int* BLKE = (int*)(ws + WS_BLKE);
    float* ROWG = (float*)(ws + WS_ROWG); bf16* Hd = (bf16*)(ws + WS_H); bf16* XR = (bf16*)(ws + WS_XR); bf16* XG = (bf16*)(ws + WS_XG); bf16* Yb = (bf16*)(ws + WS_Y); bf16* HCH = (bf16*)(ws + WS_HCH);

#define PHASE(k, ...) if (IN(k)) { { ClkStamp cs_; if ((k) == CLKP) cs_ = clk_begin(); ACC_BEGIN(k); { constexpr int rep_ = 0; (void)rep_; const int lane = fresh_lane(), tid = wave * 64 + lane; (void)tid; __VA_ARGS__ } ACC_END(k); if ((k) == CLKP) clk_end(cs_); } SEAM(k); if ((k) == PROBE_PHASE) { { constexpr int rep_ = 1; (void)rep_; const int lane = fresh_lane(), tid = wave * 64 + lane; (void)tid; __VA_ARGS__ } SEAM(k); } }
    PHASE(PH_PRO,
        transpose_all(in, ws, (LAS float*)(lds + RING_OFF + wave * 16384), gw, NGW, lane);
        if (blockIdx.x == 0) for (int i = tid; i < D / 2; i += NWAVES * 64) ((unsigned*)(HB + (size_t)NTOK * D))[i] = 0u;
        for (int i = blockIdx.x * NWAVES * 64 + tid; i < KMEAN_FLOATS; i += G * NWAVES * 64) KMEAN[i] = 0.f;
        norm_phase<1, false, false>(in.p[0], in.p[1], HB, in.p[2], WIN_LD, 3 * D, in.p[3], LF, nullptr, nullptr, nullptr, lds, tid, lane, wave, RSTD, XR);)
#define LAYER_MIX(XIN, XIN32, PQKV, PPRE, PATT, PMIX, PWO, WIN_OFF, WOUT_OFF, MGAIN, AQ, QKV_A, QKV_RSTD, WO_EPI) \
    PHASE(PQKV, pg8::Gemm g{QKV_A, (const bf16*)(ws + WIN_OFF), NTOK, 3 * D, D}; pg8::StaticOrder S; S.init(NTOK, 3 * D, G, (int)blockIdx.x); S.kst = (PQKV == PH_QKV0) ? KST_QKV0 : 0; \
        pg8::EpiQKV E{Qb, (size_t)(WS_K - WS_Q) / 2, KMEAN, QKV_RSTD, att::C2, 5, 0, rep_ ? args.probe_rt : 0}; \
        if (wave == 0) for (int it = (int)blockIdx.x; it < 160; it += G) kaug_item(LF, KAUG, it, lane);         \
        if constexpr (rep_ == 1 && QKV_MASK >= 0) { MaskOrder S2; S2.init(NTOK, 3 * D, G, (int)blockIdx.x); S2.mask = QKV_MASK; S2.nmask = QKV_NMASK; pg8::gemm_phase<pg8::EpiQKV, MaskOrder, PG8_ALIGN, PG8_SP2>(lds + RING_OFF, g, S2, E, wave); } \
        else { stagger(STG_QKV); pg8::gemm_phase<pg8::EpiQKV, pg8::StaticOrder, PG8_ALIGN, PG8_SP2>(lds + RING_OFF, g, S, E, wave); }) \
    PHASE(PATT, const att::Tens T{Qb, Kb, Vb, HB, OX1, OX2, LSE, (const att::u32x4*)KAUG, KMEAN, rep_ ? args.probe_rt : 0, SSQ}; attn_phase(T, lds, wave, ctl + AQ, rep_ ? PROBE_ATT_AB : 1, rep_ ? PROBE_ATT_C : 1);) \
    PHASE(PMIX, for (int i = blockIdx.x * NWAVES * 64 + tid; i < NTOK; i += G * NWAVES * 64) SS[i] = 0ull; mixnorm_phase(HB, OX1, OX2, LSE, MGAIN, SSQ, RAB, gw, NGW, lane);) \
    PHASE(PWO, pg8::Gemm g{HB, (const bf16*)(ws + WOUT_OFF), NTOK, D, D}; pg8::StaticOrder S; S.init(NTOK, D, G, (int)blockIdx.x); \
        WO_EPI E{XIN, XR, D, (unsigned char*)Vb, SS, XSCALE8, RAB}; \
        stagger(STG_WO); pg8::gemm_phase<WO_EPI, pg8::StaticOrder, PG8_ALIGN, PG8_SP2>(lds + RING_OFF, g, S, E, wave);)

    LAYER_MIX(XR, false, PH_QKV0, PH_PRE0, PH_ATT0, PH_MIX0, PH_WO0, WS_WIN0, WS_WOUT0, in.p[4], CW_AQ0, XR, (const float*)RSTD, pg8::EpiResS<true>)
#if DENSE_FP8
    PHASE(PH_UP0, pg8::Gemm g{Vb, (const bf16*)(ws + WS_W13_0), NTOK, 2 * FF, D / 2}; pg8::StaticOrder S; S.init(NTOK, 2 * FF, G, (int)blockIdx.x); S.kst = KST_UP0;
        pg8::EpiSwiglu<true, true> E{Hd, FF, HSCALE8, rep_ ? args.probe_rt : 0, SS};
        stagger(STG_UP); pg8::gemm_phase<pg8::EpiSwiglu<true, true>, pg8::StaticOrder, PG8_ALIGN, PG8_SP2, true>(lds + RING_OFF, g, S, E, wave, 127 - WSCALE8_EXP - XSCALE8_EXP);)
    PHASE(PH_DN0, pg8::Gemm g{Hd, (const bf16*)(ws + WS_W2_0), NTOK, D, FF / 2}; pg8::StaticOrder S; S.init(NTOK, D, G, (int)blockIdx.x); S.rev = REV_DN;
        pg8::EpiRes<false> E{XR, XR, D};
        stagger(STG_DN); pg8::gemm_phase<pg8::EpiRes<false>, pg8::StaticOrder, PG8_ALIGN, PG8_SP2, true>(lds + RING_OFF, g, S, E, wave, 127 - WSCALE8_EXP - HSCALE8_EXP);)
#else
    PHASE(PH_N2_0, norm_phase<0, false, true>(XR, in.p[6], HB, nullptr, 0, 0, nullptr, nullptr, nullptr, nullptr, nullptr, lds, tid, lane, wave);)
    PHASE(PH_UP0, pg8::Gemm g{HB, (const bf16*)(ws + WS_W13_0), NTOK, 2 * FF, D}; pg8::StaticOrder S; S.init(NTOK, 2 * FF, G, (int)blockIdx.x);
        pg8::EpiSwiglu<false> E{Hd, FF, 1.f, 0};
        pg8::gemm_phase<pg8::EpiSwiglu<false>, pg8::StaticOrder, PG8_ALIGN, PG8_SP2>(lds + RING_OFF, g, S, E, wave);)
    PHASE(PH_DN0, pg8::Gemm g{Hd, (const bf16*)(ws + WS_W2_0), NTOK, D, FF}; pg8::StaticOrder S; S.init(NTOK, D, G, (int)blockIdx.x);
        pg8::EpiRes<false> E{XR, XR, D};
        pg8::gemm_phase<pg8::EpiRes<false>, pg8::StaticOrder, PG8_ALIGN, PG8_SP2>(lds + RING_OFF, g, S, E, wave);)
#endif
    PHASE(PH_N1_1, for (int i = blockIdx.x * NWAVES * 64 + tid; i < KMEAN_FLOATS; i += G * NWAVES * 64) KMEAN[i] = 0.f;
        norm_phase<1, false, true>(XR, in.p[10], HB, in.p[11], WIN_LD, 3 * D, in.p[12], LF, nullptr, nullptr, nullptr, lds, tid, lane, wave, RSTD);)
    LAYER_MIX(XR, false, PH_QKV1, PH_PRE1, PH_ATT1, PH_MIX1, PH_WO1, WS_WIN1, WS_WOUT1, in.p[13], CW_AQ1, XR, (const float*)RSTD, pg8::EpiResS<false>)
    PHASE(PH_N2_1, norm_phase<2, true, true>(XR, in.p[15], HB, in.p[16], NEXP, 0, nullptr, nullptr, TOKE, TOKG, HIST, lds, tid, lane, wave);)
    PHASE(PH_SCAT, scatter_phase(TOKE, TOKG, HIST, TOKS, ROWG, META, BLKE, HB, XG, lds, tid, lane, wave);)
#pragma unroll 1
    for (int c = 0; c < NCHUNK; ++c) {
        const int pu = PH_MOE0 + 2 * c, pd = pu + 1;
        if (IN(pu) || IN(pd)) {
            const int nblk = __builtin_amdgcn_readfirstlane(META[0]); int nb = nblk - c * CHUNK_BLK; { const int cap = c == NCHUNK - 1 ? CHUNK_LAST : CHUNK_BLK; nb = nb < 0 ? 0 : (nb > cap ? cap : nb); }
            LAS int* be = (LAS int*)(lds + LDSX_OFF);
            __syncthreads();
            for (int i = wave * 64 + fresh_lane(); i < nb; i += NWAVES * 64) be[i] = BLKE[c * CHUNK_BLK + i];
            __syncthreads();
#define MOE_UP { ACC_BEGIN(PH_MOE0); pg8::Gemm g{XG + (size_t)c * CHUNK_BLK * 256 * (D / 2), (const bf16*)(ws + WS_W13E), nb * 256, 2 * FF, D / 2}; \
                pg8::MoeOrder S; S.init(nb * 256, 2 * FF, G, (int)blockIdx.x); S.be_lds = be; S.estride = (size_t)2 * FF * D; \
                pg8::EpiSwiglu<true> E{HCH, FF, HSCALE8, 0, nullptr}; stagger(STG_MUP); \
                pg8::gemm_phase<pg8::EpiSwiglu<true>, pg8::MoeOrder, PG8_ALIGN, PG8_SP2, true>(lds + RING_OFF, g, S, E, wave, 127 - WSCALE8_EXP); ACC_END(PH_MOE0); SEAM(pu); }
#define MOE_DN { ACC_BEGIN(PH_MOE0 + 1); pg8::Gemm g{HCH, (const bf16*)(ws + WS_W2E), nb * 256, D, FF / 2}; \
                pg8::MoeOrder S; S.init(nb * 256, D, G, (int)blockIdx.x); S.rev = REV_DN; S.be_lds = be; S.estride = (size_t)D * FF; \
                pg8::EpiY E{(unsigned char*)Yb, ROWG, c * CHUNK_BLK * 256, YSCALE8}; stagger(STG_MDN); \
                pg8::gemm_phase<pg8::EpiY, pg8::MoeOrder, PG8_ALIGN, PG8_SP2, true>(lds + RING_OFF, g, S, E, wave, 127 - WSCALE8_EXP - HSCALE8_EXP); ACC_END(PH_MOE0 + 1); SEAM(pd); }
            if (IN(pu)) { MOE_UP if (PROBE_PHASE == PH_MOE0) MOE_UP }
            if (IN(pd)) { MOE_DN if (PROBE_PHASE == PH_MOE0 + 1) MOE_DN }
        }
    }
    if (IN(PH_FINAL)) { ACC_BEGIN(PH_FINAL); final_phase(XR, out, (const unsigned char*)Yb, TOKS, in.p[20], gw, NGW, fresh_lane()); ACC_END(PH_FINAL); }
    if ((CLKACC_MASK) != 0ull && (CLK_ALL || blockIdx.x == CLK_BLOCK)) { const unsigned long long r1 = __builtin_amdgcn_s_memrealtime(); while (__builtin_amdgcn_s_memrealtime() - r1 < clk_acc) __builtin_amdgcn_s_sleep(8); }
#undef IN
#undef SEAM
}

extern "C" void kernel_launch(void* const* d_in, const int* in_sizes, int n_in, void* d_out, int out_size, void* d_ws, size_t ws_size, hipStream_t stream) {
    static int grid = 0;
    if (grid == 0) {
        if (n_in != 21 || in_sizes[0] != NTOK * D || out_size != NTOK * D || ws_size < WS_END) { fprintf(stderr, "kernel_launch: unexpected shapes (n_in %d, in0 %d, out %d, ws %zu); nothing launched\n", n_in, n_in > 0 ? in_sizes[0] : -1, out_size, ws_size); grid = -1; return; }
        int dev = 0, cus = 0, per_cu = 0;
        if (hipGetDevice(&dev) != hipSuccess || hipDeviceGetAttribute(&cus, hipDeviceAttributeMultiprocessorCount, dev) != hipSuccess) { grid = -1; return; }
        if (hipFuncSetAttribute((const void*)mk_fwd, hipFuncAttributeMaxDynamicSharedMemorySize, LDS_BYTES) != hipSuccess) { fprintf(stderr, "kernel_launch: hipFuncSetAttribute failed\n"); grid = -1; return; }
        if (hipOccupancyMaxActiveBlocksPerMultiprocessor(&per_cu, (const void*)mk_fwd, NWAVES * 64, LDS_BYTES) != hipSuccess || per_cu < 1) { fprintf(stderr, "kernel_launch: occupancy query reports %d blocks per CU\n", per_cu); }
        (void)hipGetLastError();
        grid = cus;
    }
    if (grid < 0) return;
    if (hipMemsetAsync((char*)d_ws + WS_CTL, 0, CTL_ZERO_BYTES, stream) != hipSuccess) return;
    Args a{};
    for (int i = 0; i < 21; ++i) a.in.p[i] = (const float*)d_in[i];
    a.out = (float*)d_out; a.ws = (unsigned char*)d_ws; a.probe_rt = PROBE_RT;
#if MK_ONE_LAUNCH
    a.ph_lo = 0; a.ph_hi = PH_COUNT;
    hipLaunchKernelGGL(mk_fwd, dim3(grid), dim3(NWAVES * 64), LDS_BYTES, stream, a);
#else
    for (int p = 0; p < PH_COUNT; ++p) { a.ph_lo = p; a.ph_hi = p + 1; hipLaunchKernelGGL(mk_fwd, dim3(grid), dim3(NWAVES * 64), LDS_BYTES, stream, a); }
#endif
}
```
